# Optimizing an MI355X kernel written in HIP

```python
import jax
import jax.numpy as jnp
from jax import lax
import numpy as np

D_MODEL = 2048
BATCH = 1
SEQ = 16384
DEPTH = 1

N_MEM = 256
HEAD_DIM = 128
EPS = 1e-6
N_HEADS_A = (D_MODEL // 2) // HEAD_DIM
DILATED_PATTERNS = ((128, 1), (512, 4), (2048, 16))
ATTN_BLOCK = 128
N_HEADS_B = (D_MODEL // 2) // HEAD_DIM
DK_B = HEAD_DIM
DV_B = HEAD_DIM
CONV_WIDTH = 4
DELTA_CHUNK = 64
W_A = N_HEADS_A * HEAD_DIM
W_BK = N_HEADS_B * DK_B
W_BV = N_HEADS_B * DV_B
MIX_WIDTH = W_A + W_BV
D_IN = 3 * W_A + 2 * W_BK + 2 * W_BV + 2 * N_HEADS_B
N_HEADS_MEM = 4
N_GROUPS = 8
EXPERTS_PER_GROUP = 8
N_EXPERTS = N_GROUPS * EXPERTS_PER_GROUP
TOP_K_EXPERT = 2
D_EXPERT = D_MODEL // 4
MOE_BLOCK = 128

kernel_name = 'hybrid_dilated_deltanet_hmoe'


def rms_norm(x, g):
    x32 = x.astype(jnp.float32)
    return x32 * lax.rsqrt(jnp.mean(x32 * x32, axis=-1, keepdims=True) + EPS) * g.astype(jnp.float32)


def l2_normalize(x):
    return x * lax.rsqrt(jnp.sum(x * x, axis=-1, keepdims=True) + EPS)


def alibi_slopes(n_heads):
    return jnp.asarray(2.0 ** (-8.0 * np.arange(1, n_heads + 1) / n_heads), dtype=jnp.float32)


def dilated_window_attn(q, k, v, slopes, window, dilation):
    B, S, H, Dh = q.shape
    d = dilation
    n_back = window // d
    L = S // d
    nb = -(-L // ATTN_BLOCK)
    Lp = nb * ATTN_BLOCK
    Z = B * d

    def by_residue(t):
        t = t.reshape(B, L, d, H, Dh).transpose(0, 2, 3, 1, 4).reshape(Z, H, L, Dh)
        return jnp.pad(t, ((0, 0), (0, 0), (0, Lp - L), (0, 0)))

    def band(t):
        tb = t.reshape(Z, H, nb, ATTN_BLOCK, Dh)
        prev = jnp.pad(tb, ((0, 0), (0, 0), (1, 0), (0, 0), (0, 0)))[:, :, :-1]
        return jnp.concatenate([prev, tb], axis=3)

    qb = by_residue(q).reshape(Z, H, nb, ATTN_BLOCK, Dh)
    kb = band(by_residue(k))
    vb = band(by_residue(v))
    s = jnp.einsum('zhnqd,zhnkd->zhnqk', qb, kb) * (Dh ** -0.5)
    qi = jnp.arange(ATTN_BLOCK)[:, None] + ATTN_BLOCK
    ki = jnp.arange(2 * ATTN_BLOCK)[None, :]
    dist = qi - ki
    key_idx = (jnp.arange(nb) * ATTN_BLOCK - ATTN_BLOCK)[:, None, None] + ki[None]
    valid = (dist >= 0) & (dist <= n_back) & (key_idx >= 0)
    bias = -slopes[:, None, None, None] * (d * dist).astype(jnp.float32)
    s = jnp.where(valid, s + bias, -jnp.inf)
    lse = jax.nn.logsumexp(s, axis=-1)
    p = jnp.exp(s - lse[..., None])
    o = jnp.einsum('zhnqk,zhnkd->zhnqd', p, vb)
    o = o.reshape(Z, H, Lp, Dh)[:, :, :L].reshape(B, d, H, L, Dh).transpose(0, 3, 1, 2, 4).reshape(B, S, H, Dh)
    lse = lse.reshape(Z, H, Lp)[:, :, :L].reshape(B, d, H, L).transpose(0, 3, 1, 2).reshape(B, S, H)
    return o, lse


def dilated_attention(q, k, v):
    slopes = alibi_slopes(q.shape[2])
    outs = []
    lses = []
    for window, dilation in DILATED_PATTERNS:
        o, lse = dilated_window_attn(q, k, v, slopes, window, dilation)
        outs.append(o)
        lses.append(lse)
    w = jax.nn.softmax(jnp.stack(lses, axis=0), axis=0)
    return jnp.sum(w[..., None] * jnp.stack(outs, axis=0), axis=0)


def causal_depthwise_conv(u, w):
    C = u.shape[-1]
    return lax.conv_general_dilated(u, w[:, None, :].astype(u.dtype), (1,), [(CONV_WIDTH - 1, 0)],
                                    dimension_numbers=('NWC', 'WIO', 'NWC'), feature_group_count=C)


def gated_delta_rule(q, k, v, g, beta):
    B, S, H, dk = q.shape
    dv = v.shape[-1]
    C = DELTA_CHUNK
    N = S // C

    def chunks(t):
        return jnp.moveaxis(t.reshape((B, N, C, H) + t.shape[3:]), 3, 1)

    q = chunks(q * (dk ** -0.5))
    k = chunks(k)
    v = chunks(v)
    beta = chunks(beta)
    g = jnp.cumsum(chunks(g), axis=-1)
    causal = jnp.tril(jnp.ones((C, C), dtype=bool))
    strict = jnp.tril(jnp.ones((C, C), dtype=bool), -1)
    decay = jnp.exp(jnp.where(causal, g[..., :, None] - g[..., None, :], -jnp.inf))
    kb = k * beta[..., None]
    a_mat = jnp.where(strict, jnp.einsum('bhncd,bhnsd->bhncs', kb, k) * decay, 0.0)
    eye = jnp.eye(C, dtype=a_mat.dtype)
    t_mat = lax.linalg.triangular_solve(eye + a_mat, jnp.broadcast_to(eye, a_mat.shape),
                                        left_side=True, lower=True, unit_diagonal=True)
    u = jnp.einsum('bhncs,bhnsv->bhncv', t_mat, v * beta[..., None])
    w = jnp.einsum('bhncs,bhnsk->bhnck', t_mat, kb * jnp.exp(g)[..., None])
    qk = jnp.einsum('bhncd,bhnsd->bhncs', q, k) * decay
    g_last = g[..., -1]
    q_dec = q * jnp.exp(g)[..., None]
    k_dec = k * jnp.exp(g_last[..., None] - g)[..., None]

    def step(state, inp):
        q_i, k_i, u_i, w_i, qk_i, gl_i = inp
        v_new = u_i - jnp.einsum('bhck,bhkv->bhcv', w_i, state)
        o_i = jnp.einsum('bhck,bhkv->bhcv', q_i, state) + jnp.einsum('bhcs,bhsv->bhcv', qk_i, v_new)
        state = state * jnp.exp(gl_i)[..., None, None] + jnp.einsum('bhck,bhcv->bhkv', k_i, v_new)
        return state, o_i

    xs = (jnp.moveaxis(q_dec, 2, 0), jnp.moveaxis(k_dec, 2, 0), jnp.moveaxis(u, 2, 0),
          jnp.moveaxis(w, 2, 0), jnp.moveaxis(qk, 2, 0), jnp.moveaxis(g_last, 2, 0))
    state0 = jnp.zeros((B, H, dk, dv), dtype=jnp.float32)
    _, o = lax.scan(step, state0, xs)
    return o.transpose(1, 0, 3, 2, 4).reshape(B, S, H, dv)


def gated_deltanet(qkv, z, b, a, conv_w, a_log, dt_bias, g_out):
    B, S, _ = qkv.shape
    qkv = jax.nn.silu(causal_depthwise_conv(qkv, conv_w))
    q, k, v = jnp.split(qkv, [W_BK, 2 * W_BK], axis=-1)
    q = l2_normalize(q.reshape(B, S, N_HEADS_B, DK_B))
    k = l2_normalize(k.reshape(B, S, N_HEADS_B, DK_B))
    v = v.reshape(B, S, N_HEADS_B, DV_B)
    beta = jax.nn.sigmoid(b)
    g = -jnp.exp(a_log.astype(jnp.float32)) * jax.nn.softplus(a + dt_bias)
    o = gated_delta_rule(q, k, v, g, beta)
    o = rms_norm(o, g_out) * jax.nn.silu(z.reshape(B, S, N_HEADS_B, DV_B))
    return o.reshape(B, S, W_BV)


def memory_cross_attention(h, mem_n, w_q, w_kv, w_o):
    B, S, _ = h.shape
    M = mem_n.shape[1]
    q = (h @ w_q).reshape(B, S, N_HEADS_MEM, HEAD_DIM)
    k, v = jnp.split(mem_n @ w_kv, 2, axis=-1)
    k = k.reshape(B, M, N_HEADS_MEM, HEAD_DIM)
    v = v.reshape(B, M, N_HEADS_MEM, HEAD_DIM)
    p = jax.nn.softmax(jnp.einsum('bshd,bmhd->bhsm', q, k) * (HEAD_DIM ** -0.5), axis=-1)
    o = jnp.einsum('bhsm,bmhd->bshd', p, v).reshape(B, S, N_HEADS_MEM * HEAD_DIM)
    return o @ w_o


def hierarchical_moe(h, w_group, b_group, w_expert, b_expert, w_gate, w_up, w_down):
    B, S, D = h.shape
    T = B * S
    t = h.reshape(T, D)
    g_logits = t @ w_group + b_group
    g_sel = jnp.argmax(g_logits, axis=-1)
    g_gate = jnp.take_along_axis(jax.nn.softmax(g_logits, axis=-1), g_sel[:, None], axis=1)
    e_logits = (t @ w_expert + b_expert).reshape(T, N_GROUPS, EXPERTS_PER_GROUP)
    e_logits = jnp.take_along_axis(e_logits, g_sel[:, None, None], axis=1)[:, 0]
    top_v, top_i = lax.top_k(e_logits, TOP_K_EXPERT)
    weights = g_gate * jax.nn.softmax(top_v, axis=-1)
    expert_id = g_sel[:, None] * EXPERTS_PER_GROUP + top_i

    M = T * TOP_K_EXPERT
    e_flat = expert_id.reshape(M)
    w_flat = weights.reshape(M)
    tok_flat = jnp.repeat(jnp.arange(T, dtype=jnp.int32), TOP_K_EXPERT)
    order = jnp.argsort(e_flat)
    e_sorted = e_flat[order]
    counts = jnp.bincount(e_flat, length=N_EXPERTS)
    padded = ((counts + MOE_BLOCK - 1) // MOE_BLOCK) * MOE_BLOCK
    start = jnp.cumsum(counts) - counts
    pstart = jnp.cumsum(padded) - padded
    dest = pstart[e_sorted] + jnp.arange(M) - start[e_sorted]
    P = (-(-M // MOE_BLOCK)) * MOE_BLOCK + N_EXPERTS * MOE_BLOCK
    n_blocks = P // MOE_BLOCK
    buf_tok = jnp.full((P,), T, dtype=jnp.int32).at[dest].set(tok_flat[order])
    buf_w = jnp.zeros((P,), dtype=t.dtype).at[dest].set(w_flat[order])
    block_expert = jnp.minimum(jnp.searchsorted(jnp.cumsum(padded), jnp.arange(n_blocks) * MOE_BLOCK, side='right'),
                               N_EXPERTS - 1)
    t_pad = jnp.concatenate([t, jnp.zeros((1, D), dtype=t.dtype)], axis=0)
    xb = t_pad[buf_tok].reshape(n_blocks, MOE_BLOCK, D)

    def expert_block(args):
        x_blk, e = args
        hid = jax.nn.silu(x_blk @ w_gate[e]) * (x_blk @ w_up[e])
        return hid @ w_down[e]

    yb = lax.map(expert_block, (xb, block_expert)).reshape(P, D)
    y = jnp.zeros((T + 1, D), dtype=yb.dtype).at[buf_tok].add(yb * buf_w[:, None])[:T]
    return y.reshape(B, S, D)


def setup_inputs(seed: int = 0) -> dict:
    key = jax.random.key(seed)
    ks = jax.random.split(key, 26)
    L = DEPTH
    f32 = jnp.float32

    def nrm(k, shape, scale):
        return jax.random.normal(k, shape, f32) * scale

    def gain(k, shape):
        return 1.0 + 0.02 * jax.random.normal(k, shape, f32)

    dt = jnp.exp(jax.random.uniform(ks[6], (L, N_HEADS_B), f32, minval=np.log(1e-3), maxval=np.log(1e-1)))
    return {
        'x': nrm(ks[0], (BATCH, SEQ, D_MODEL), 1.0),
        'mem': nrm(ks[1], (BATCH, N_MEM, D_MODEL), 1.0),
        'g_mix': gain(ks[2], (L, D_MODEL)),
        'w_in': nrm(ks[3], (L, D_MODEL, D_IN), D_MODEL ** -0.5),
        'conv_w': nrm(ks[4], (L, CONV_WIDTH, W_BK + W_BK + W_BV), CONV_WIDTH ** -0.5),
        'a_log': jnp.log(jax.random.uniform(ks[5], (L, N_HEADS_B), f32, minval=1.0, maxval=16.0)),
        'dt_bias': dt + jnp.log(-jnp.expm1(-dt)),
        'g_delta_out': gain(ks[7], (L, DV_B)),
        'g_attn_out': gain(ks[8], (L, W_A)),
        'w_out': nrm(ks[9], (L, MIX_WIDTH, D_MODEL), MIX_WIDTH ** -0.5),
        'g_cross': gain(ks[10], (L, D_MODEL)),
        'g_mem': gain(ks[11], (L, D_MODEL)),
        'w_q_mem': nrm(ks[12], (L, D_MODEL, N_HEADS_MEM * HEAD_DIM), D_MODEL ** -0.5),
        'w_kv_mem': nrm(ks[13], (L, D_MODEL, 2 * N_HEADS_MEM * HEAD_DIM), D_MODEL ** -0.5),
        'w_o_mem': nrm(ks[14], (L, N_HEADS_MEM * HEAD_DIM, D_MODEL), (N_HEADS_MEM * HEAD_DIM) ** -0.5),
        'g_moe': gain(ks[15], (L, D_MODEL)),
        'w_group': nrm(ks[16], (L, D_MODEL, N_GROUPS), D_MODEL ** -0.5),
        'b_group': nrm(ks[17], (L, N_GROUPS), 0.01),
        'w_expert': nrm(ks[18], (L, D_MODEL, N_EXPERTS), D_MODEL ** -0.5),
        'b_expert': nrm(ks[19], (L, N_EXPERTS), 0.01),
        'w_gate': nrm(ks[20], (L, N_EXPERTS, D_MODEL, D_EXPERT), D_MODEL ** -0.5),
        'w_up': nrm(ks[21], (L, N_EXPERTS, D_MODEL, D_EXPERT), D_MODEL ** -0.5),
        'w_down': nrm(ks[22], (L, N_EXPERTS, D_EXPERT, D_MODEL), D_EXPERT ** -0.5),
        'g_final': gain(ks[23], (D_MODEL,)),
    }


def reference(x, mem, g_mix, w_in, conv_w, a_log, dt_bias, g_delta_out, g_attn_out, w_out,
              g_cross, g_mem, w_q_mem, w_kv_mem, w_o_mem,
              g_moe, w_group, b_group, w_expert, b_expert, w_gate, w_up, w_down, g_final):
    in_dtype = x.dtype
    h = x.astype(jnp.float32)
    B, S, _ = h.shape
    splits = [W_A, 2 * W_A, 3 * W_A, 3 * W_A + 2 * W_BK + W_BV, 3 * W_A + 2 * W_BK + 2 * W_BV,
              3 * W_A + 2 * W_BK + 2 * W_BV + N_HEADS_B]
    for l in range(DEPTH):
        u = rms_norm(h, g_mix[l])
        proj = u @ w_in[l]
        qa, ka, va, qkv_d, z_d, b_d, a_d = jnp.split(proj, splits, axis=-1)
        attn = dilated_attention(qa.reshape(B, S, N_HEADS_A, HEAD_DIM),
                                 ka.reshape(B, S, N_HEADS_A, HEAD_DIM),
                                 va.reshape(B, S, N_HEADS_A, HEAD_DIM))
        attn = rms_norm(attn.reshape(B, S, W_A), g_attn_out[l])
        delta = gated_deltanet(qkv_d, z_d, b_d, a_d, conv_w[l], a_log[l], dt_bias[l], g_delta_out[l])
        h = h + jnp.concatenate([attn, delta], axis=-1) @ w_out[l]
        mem_n = rms_norm(mem, g_mem[l])
        h = h + memory_cross_attention(rms_norm(h, g_cross[l]), mem_n, w_q_mem[l], w_kv_mem[l], w_o_mem[l])
        h = h + hierarchical_moe(rms_norm(h, g_moe[l]), w_group[l], b_group[l], w_expert[l], b_expert[l],
                                 w_gate[l], w_up[l], w_down[l])
    return rms_norm(h, g_final).astype(in_dtype)
```

```cpp
#include <hip/hip_runtime.h>
#include <cstdio>
#include <cstdint>

#define LAS __attribute__((address_space(3)))
#define GAS __attribute__((address_space(1)))
typedef unsigned short bf16;
typedef short bf16x8 __attribute__((ext_vector_type(8)));
typedef short s16x4 __attribute__((ext_vector_type(4)));
typedef float f32x2 __attribute__((ext_vector_type(2)));
typedef float f32x4 __attribute__((ext_vector_type(4)));
typedef float f32x16 __attribute__((ext_vector_type(16)));
typedef unsigned u32x2 __attribute__((ext_vector_type(2)));
typedef unsigned u32x4 __attribute__((ext_vector_type(4)));
typedef __bf16 bf16x2_t __attribute__((ext_vector_type(2)));
typedef GAS unsigned gu32;

#ifndef MK_N_LAUNCHES
#define MK_N_LAUNCHES 1
#endif

constexpr int S = 16384, D = 2048, NMEM = 256, HD = 128;
constexpr int NCH = S / 64;
constexpr int NPROJ = 7168, LDWIN = 7184;
constexpr int NEXP = 64, DE = 512;
constexpr float EPS = 1e-6f;
constexpr float LOG2E = 1.4426950408889634f, LN2 = 0.6931471805599453f;

constexpr size_t MiB = 1u << 20;
constexpr size_t WS_CTL = 0, CTL_ZERO_BYTES = 64 * 1024;
constexpr size_t WS_WIN = 1 * MiB, WS_WOUT = 29 * MiB, WS_WQ = 37 * MiB, WS_WKV = 39 * MiB, WS_WO = 43 * MiB, WS_WR = 45 * MiB, WS_WGU = 46 * MiB, WS_WD = 302 * MiB;
constexpr size_t WS_QKVA = 430 * MiB, WS_QKVD = 526 * MiB, WS_Z = 622 * MiB;
constexpr size_t WS_MIX = 430 * MiB;
constexpr size_t WS_HID = 430 * MiB, WS_Y = 478 * MiB;
constexpr size_t WS_ATTO = 654 * MiB, WS_LSE = 750 * MiB;
constexpr size_t WS_H2B = 654 * MiB;
constexpr size_t WS_XN = 752 * MiB;
constexpr size_t WS_QDEC = 752 * MiB, WS_KDT = 784 * MiB, WS_WW = 816 * MiB, WS_UT = 848 * MiB, WS_QKM = 912 * MiB, WS_QN = 928 * MiB, WS_KN = 960 * MiB;
constexpr size_t WS_ODELTA = 928 * MiB;
constexpr size_t WS_H1B = 752 * MiB, WS_QMEM = 816 * MiB, WS_OMEM = 832 * MiB, WS_LOGITS = 848 * MiB;
constexpr size_t WS_BA = 992 * MiB, WS_MEMN = 994 * MiB, WS_KVMEM = 995 * MiB, WS_SSQ1 = 996 * MiB, WS_SSQ2 = 998 * MiB, WS_RSTD2 = 1000 * MiB;
constexpr size_t WS_WGT = 1000 * MiB + 512 * 1024, WS_LIST = 1001 * MiB, WS_GLAST = 1005 * MiB, WS_END = 1006 * MiB;
constexpr int CW_TMO = 0, CW_CNT = 1024  , CW_BAR = 4096;

constexpr int RING_BYTES = 131072;
constexpr int MISC_OFF = RING_BYTES;
constexpr int PTAB_OFF = MISC_OFF + 1024;
constexpr int LDS_BYTES = 147456;
constexpr int WAVE_LDS = 16384;
constexpr int PREP_SMALL_OFF = MISC_OFF + 4096;

__device__ __forceinline__ unsigned pk2(float lo, float hi) { f32x2 v = {lo, hi}; return __builtin_bit_cast(unsigned, __builtin_convertvector(v, bf16x2_t)); }
__device__ __forceinline__ float bf2f(unsigned short b) { return __uint_as_float((unsigned)b << 16); }
__device__ __forceinline__ bf16x8 pack8(f32x4 a, f32x4 b) { u32x4 w = {pk2(a[0], a[1]), pk2(a[2], a[3]), pk2(b[0], b[1]), pk2(b[2], b[3])}; return __builtin_bit_cast(bf16x8, w); }
__device__ __forceinline__ float wave_sum(float v) {
#pragma unroll
    for (int o = 1; o < 64; o <<= 1) v += __shfl_xor(v, o);
    return v;
}

namespace pg8 {
#define PG8_LAS __attribute__((address_space(3)))
typedef unsigned short bf16_t;
constexpr int BM = 256, BK = 64, HALF = 128, HTB = HALF * BK * 2, STAGE_BYTES = 8 * HTB, NXCD = 8, WGM = 8;
__host__ __device__ __forceinline__ int lds_byte(int r, int c) { const int st = (r >> 4) * 2 + (c >> 5), rr = r & 15, cc = c & 31, ob = rr * 64 + cc * 2; return st * 1024 + (ob ^ (((ob >> 9) & 1) << 5)); }
__host__ __device__ __forceinline__ void stage_rc(int b, int& R, int& C) { const int st = b / 1024, sb = b % 1024, swz = sb ^ (((sb >> 9) & 1) << 5); R = (st >> 1) * 16 + swz / 64; C = (st & 1) * 32 + (swz % 64) / 2; }
__host__ __device__ __forceinline__ int perm32(int rho) { const int n = rho >> 4, i = rho & 15; return 8 * (i >> 2) + 4 * n + (i & 3); }

struct Unit { int pm, pn, e, roff, cnt; };
struct Gemm { const bf16_t* A; const bf16_t* Bt; int K; size_t bstride; const int* list; };

struct StaticOrder {
    int nM, nN, nwg, G, c;
    __host__ __device__ void init(int M, int N, int G_, int c_) { nM = M / BM; nN = N / BM; nwg = nM * nN; G = G_; c = c_; }
    __host__ __device__ bool next(int i, Unit& u) const {
        if (c < 0) return false;
        const long L = (long)i * G + c; if (L >= nwg) return false;
        int wgid = (int)L; { const int q = nwg / NXCD, r = nwg % NXCD, xcd = wgid % NXCD, off = wgid / NXCD; wgid = (xcd < r ? xcd * (q + 1) : r * (q + 1) + (xcd - r) * q) + off; }
        const int nig = WGM * nN, gid = wgid / nig, fm = gid * WGM, gsz = (nM - fm) < WGM ? (nM - fm) : WGM;
        u.pm = fm + ((wgid % nig) % gsz); u.pn = (wgid % nig) / gsz; u.e = 0; u.roff = 0; u.cnt = 0; return true;
    }
};
template <int LNT> struct MoeOrder {
    const PG8_LAS int* ptab; int G, vcu;
    __device__ bool next(int i, Unit& u) const {
        const int U = i * G + vcu, p = U >> LNT, np = ptab[576];
        if (p >= np) return false;
        u.pm = p; u.pn = U & ((1 << LNT) - 1); u.e = ptab[p]; u.roff = ptab[192 + p]; u.cnt = ptab[384 + p]; return true;
    }
};

template <class Epi, class Sched, bool ALIGN_EPI, bool SP2, bool GATHER>
__device__ __forceinline__ void gemm_phase(PG8_LAS unsigned char* lds, const Gemm g, const Sched& S, const Epi& E) {
    const int tid = threadIdx.x, wid = __builtin_amdgcn_readfirstlane(tid >> 6), lane = tid & 63, wr = wid >> 2, wc = wid & 3, fr = lane & 15, fq = lane >> 4;
    const int K = g.K, nt = K / BK;
    unsigned voffA[2], voffB[2]; int RA[2], CA2[2];
#pragma unroll
    for (int i = 0; i < 2; ++i) { int R, C; stage_rc(tid * 16 + i * 8192, R, C); const int Rb = Epi::PERM ? ((R & ~31) + perm32(R & 31)) : R;
        voffA[i] = (unsigned)(R * K + C) * 2u; voffB[i] = (unsigned)(Rb * K + C) * 2u; RA[i] = R; CA2[i] = C * 2; }
    const size_t kstep = (size_t)(BK * 2);
    const size_t hstep = (size_t)HALF * K * 2;
    const size_t tstep = 2 * hstep;
    const unsigned ldsw = (unsigned)wid * 1024u;
    const int aoff = lds_byte(wr * 64 + fr, fq * 8), boff = lds_byte(wc * 32 + fr, fq * 8);
#define PG8_SA(b, h) (((b) * 2 + (h)) * HTB)
#define PG8_SB(b, h) ((4 + (b) * 2 + (h)) * HTB)
#define PG8_STAGE(bufoff, gbase, voff) do { _Pragma("unroll") for (int _i = 0; _i < 2; ++_i) \
        __builtin_amdgcn_global_load_lds((const unsigned*)((const char*)(gbase) + (voff)[_i]), (PG8_LAS unsigned*)(lds + (bufoff) + ldsw + _i * 8192), 16, 0, 0); } while (0)
#define PG8_STAGEA(bufoff, gbase, h, V) do { if constexpr (GATHER) { _Pragma("unroll") for (int _i = 0; _i < 2; ++_i) \
        __builtin_amdgcn_global_load_lds((const unsigned*)((const char*)(gbase) + V[h][_i]), (PG8_LAS unsigned*)(lds + (bufoff) + ldsw + _i * 8192), 16, 0, 0); } \
        else { PG8_STAGE(bufoff, (const char*)(gbase) + (h) * hstep, voffA); } } while (0)
#define PG8_LDA(dst, b, h) do { _Pragma("unroll") for (int m = 0; m < 4; ++m) _Pragma("unroll") for (int k = 0; k < 2; ++k) dst[m][k] = *(const PG8_LAS bf16x8*)(lds + PG8_SA(b, h) + aoff + m * 2048 + k * 1024); } while (0)
#define PG8_LDB(dst, b, h) do { _Pragma("unroll") for (int n = 0; n < 2; ++n) _Pragma("unroll") for (int k = 0; k < 2; ++k) dst[n][k] = *(const PG8_LAS bf16x8*)(lds + PG8_SB(b, h) + boff + n * 2048 + k * 1024); } while (0)
#define PG8_MMA(ai, bj, At, Bt) do { __builtin_amdgcn_s_setprio(1); _Pragma("unroll") for (int m = 0; m < 4; ++m) _Pragma("unroll") for (int n = 0; n < 2; ++n) _Pragma("unroll") for (int k = 0; k < 2; ++k) \
        acc[ai][bj][m][n] = __builtin_amdgcn_mfma_f32_16x16x32_bf16(Bt[n][k], At[m][k], acc[ai][bj][m][n], 0, 0, 0); __builtin_amdgcn_s_setprio(0); } while (0)
#define PG8_WAIT_V(n) asm volatile("s_waitcnt vmcnt(" #n ")" ::: "memory")
#define PG8_WAIT_L(n) asm volatile("s_waitcnt lgkmcnt(" #n ")" ::: "memory")
#define PG8_BAR __builtin_amdgcn_s_barrier()
#define PG8_SCHED __builtin_amdgcn_sched_barrier(0)
#define PG8_GOFF(V, u) do { if constexpr (GATHER) { _Pragma("unroll") for (int _h = 0; _h < 2; ++_h) _Pragma("unroll") for (int _i = 0; _i < 2; ++_i) { \
        int _idx = (u).roff + 128 * _h + RA[_i]; _idx = _idx < (u).cnt ? _idx : 0; const int _id = g.list[(size_t)(u).e * 16384 + _idx]; \
        V[_h][_i] = (unsigned)(_id >> 1) * (unsigned)(K * 2) + (unsigned)CA2[_i]; } } } while (0)
    Unit cur, nxt; int ui = 0;
    if (!S.next(0, cur)) return;
    f32x4 acc[2][2][4][2];
#pragma unroll
    for (int a = 0; a < 2; ++a)
#pragma unroll
        for (int b = 0; b < 2; ++b)
#pragma unroll
            for (int m = 0; m < 4; ++m)
#pragma unroll
                for (int n = 0; n < 2; ++n) acc[a][b][m][n] = (f32x4){0.f, 0.f, 0.f, 0.f};
    bf16x8 At[4][2], B0[2][2], B1[2][2];
    unsigned cV[2][2] = {{0u, 0u}, {0u, 0u}}, nV[2][2] = {{0u, 0u}, {0u, 0u}}, sV[2][2] = {{0u, 0u}, {0u, 0u}};
    PG8_GOFF(cV, cur);
    const char* cA = GATHER ? (const char*)g.A : (const char*)g.A + (size_t)cur.pm * tstep;
    const char* cB = (const char*)g.Bt + ((size_t)cur.e * g.bstride) * 2 + (size_t)cur.pn * tstep;
    if constexpr (SP2) {
        PG8_STAGE(PG8_SB(0, 0), cB, voffB); PG8_STAGE(PG8_SB(0, 1), cB + hstep, voffB); PG8_STAGEA(PG8_SA(0, 0), cA, 0, cV); PG8_STAGEA(PG8_SA(0, 1), cA, 1, cV);
        if (wr == 1) PG8_BAR;
        PG8_WAIT_V(2); PG8_BAR;
        PG8_STAGE(PG8_SB(1, 0), cB + kstep, voffB); PG8_STAGEA(PG8_SA(1, 0), cA + kstep, 0, cV); PG8_STAGE(PG8_SB(1, 1), cB + hstep + kstep, voffB);
        PG8_WAIT_V(6); PG8_BAR;
    } else {
        PG8_STAGE(PG8_SB(0, 0), cB, voffB); PG8_STAGEA(PG8_SA(0, 0), cA, 0, cV); PG8_STAGE(PG8_SB(0, 1), cB + hstep, voffB); PG8_STAGEA(PG8_SA(0, 1), cA, 1, cV);
        if (wr == 1) PG8_BAR;
        PG8_WAIT_V(4); PG8_BAR;
        PG8_STAGE(PG8_SB(1, 0), cB + kstep, voffB); PG8_STAGEA(PG8_SA(1, 0), cA + kstep, 0, cV); PG8_STAGE(PG8_SB(1, 1), cB + hstep + kstep, voffB);
        PG8_WAIT_V(6); PG8_BAR;
    }
    for (;;) {
        const bool has_next = S.next(ui + 1, nxt);
        if (has_next) { PG8_GOFF(nV, nxt); }
        const char* nA = has_next ? (GATHER ? (const char*)g.A : (const char*)g.A + (size_t)nxt.pm * tstep) : cA;
        const char* nB = has_next ? (const char*)g.Bt + ((size_t)nxt.e * g.bstride) * 2 + (size_t)nxt.pn * tstep : cB;
        if constexpr (GATHER) { if (!has_next) {
#pragma unroll
            for (int h = 0; h < 2; ++h)
#pragma unroll
                for (int i = 0; i < 2; ++i) nV[h][i] = cV[h][i]; } }
        for (int t = 0; t < nt; t += 2) {
            const bool last = (t == nt - 2);
            const char* a1 = cA + (size_t)(t + 1) * kstep;
            const char* a2 = last ? nA : cA + (size_t)(t + 2) * kstep; const char* b2 = last ? nB : cB + (size_t)(t + 2) * kstep;
            const char* a3 = a2 + kstep; const char* b3 = b2 + kstep;
            if constexpr (GATHER) {
#pragma unroll
                for (int h = 0; h < 2; ++h)
#pragma unroll
                    for (int i = 0; i < 2; ++i) sV[h][i] = last ? nV[h][i] : cV[h][i]; }
            if constexpr (SP2) {
            PG8_LDB(B0, 0, 0); PG8_LDB(B1, 0, 1); PG8_SCHED; PG8_LDA(At, 0, 0); PG8_STAGEA(PG8_SA(1, 1), a1, 1, cV);
            PG8_WAIT_V(8); PG8_WAIT_L(0); PG8_BAR; PG8_MMA(0, 0, At, B0); PG8_MMA(0, 1, At, B1); PG8_BAR; PG8_SCHED;
            PG8_LDA(At, 0, 1); PG8_STAGE(PG8_SB(0, 0), b2, voffB); PG8_STAGE(PG8_SB(0, 1), b2 + hstep, voffB); PG8_STAGEA(PG8_SA(0, 0), a2, 0, sV);
            PG8_WAIT_V(8); PG8_WAIT_L(0); PG8_BAR; PG8_MMA(1, 0, At, B0); PG8_MMA(1, 1, At, B1); PG8_BAR; PG8_SCHED;
            PG8_LDB(B0, 1, 0); PG8_LDB(B1, 1, 1); PG8_SCHED; PG8_LDA(At, 1, 0); PG8_STAGEA(PG8_SA(0, 1), a2, 1, sV);
            PG8_WAIT_V(8); PG8_WAIT_L(0); PG8_BAR; PG8_MMA(0, 0, At, B0); PG8_MMA(0, 1, At, B1); PG8_BAR; PG8_SCHED;
            PG8_LDA(At, 1, 1); PG8_STAGE(PG8_SB(1, 0), b3, voffB); PG8_STAGE(PG8_SB(1, 1), b3 + hstep, voffB); PG8_STAGEA(PG8_SA(1, 0), a3, 0, sV);
            PG8_WAIT_V(8); PG8_WAIT_L(0); PG8_BAR; PG8_MMA(1, 0, At, B0); PG8_MMA(1, 1, At, B1); PG8_BAR; PG8_SCHED;
            } else {
            PG8_LDB(B0, 0, 0); PG8_SCHED; PG8_LDA(At, 0, 0); PG8_STAGEA(PG8_SA(1, 1), a1, 1, cV);
            PG8_WAIT_L(8); PG8_BAR; PG8_WAIT_L(0); PG8_MMA(0, 0, At, B0); PG8_BAR; PG8_SCHED;
            PG8_LDB(B1, 0, 1); PG8_STAGE(PG8_SB(0, 0), b2, voffB);
            PG8_BAR; PG8_WAIT_L(0); PG8_MMA(0, 1, At, B1); PG8_BAR;
            PG8_LDA(At, 0, 1); PG8_STAGEA(PG8_SA(0, 0), a2, 0, sV);
            PG8_BAR; PG8_WAIT_L(0); PG8_MMA(1, 0, At, B0); PG8_BAR; PG8_SCHED;
            PG8_STAGE(PG8_SB(0, 1), b2 + hstep, voffB);
            PG8_WAIT_V(6); PG8_BAR; PG8_MMA(1, 1, At, B1); PG8_BAR;
            PG8_LDB(B0, 1, 0); PG8_SCHED; PG8_LDA(At, 1, 0); PG8_STAGEA(PG8_SA(0, 1), a2, 1, sV);
            PG8_WAIT_L(8); PG8_BAR; PG8_WAIT_L(0); PG8_MMA(0, 0, At, B0); PG8_BAR; PG8_SCHED;
            PG8_LDB(B1, 1, 1); PG8_STAGE(PG8_SB(1, 0), b3, voffB);
            PG8_BAR; PG8_WAIT_L(0); PG8_MMA(0, 1, At, B1); PG8_BAR;
            PG8_LDA(At, 1, 1); PG8_STAGEA(PG8_SA(1, 0), a3, 0, sV);
            PG8_BAR; PG8_WAIT_L(0); PG8_MMA(1, 0, At, B0); PG8_BAR; PG8_SCHED;
            PG8_STAGE(PG8_SB(1, 1), b3 + hstep, voffB);
            PG8_WAIT_V(6); PG8_BAR; PG8_MMA(1, 1, At, B1); PG8_BAR;
            }
        }
        if constexpr (ALIGN_EPI) { if (wr == 0) PG8_BAR; }
        E(acc, cur, wr, wc, fr, fq);
        if (!has_next) break;
#pragma unroll
        for (int a = 0; a < 2; ++a)
#pragma unroll
            for (int b = 0; b < 2; ++b)
#pragma unroll
                for (int m = 0; m < 4; ++m)
#pragma unroll
                    for (int n = 0; n < 2; ++n) acc[a][b][m][n] = (f32x4){0.f, 0.f, 0.f, 0.f};
        cur = nxt; cA = nA; cB = nB; ++ui;
        if constexpr (GATHER) {
#pragma unroll
            for (int h = 0; h < 2; ++h)
#pragma unroll
                for (int i = 0; i < 2; ++i) cV[h][i] = nV[h][i]; }
        if constexpr (ALIGN_EPI) { if (wr == 1) PG8_BAR; }
    }
    PG8_WAIT_V(0);
    if constexpr (!ALIGN_EPI) { if (wr == 0) PG8_BAR; }
    PG8_BAR;
#undef PG8_SA
#undef PG8_SB
#undef PG8_STAGE
#undef PG8_STAGEA
#undef PG8_LDA
#undef PG8_LDB
#undef PG8_MMA
#undef PG8_WAIT_V
#undef PG8_WAIT_L
#undef PG8_BAR
#undef PG8_SCHED
#undef PG8_GOFF
}
}
struct EpiProj {
    static constexpr bool PERM = true;
    bf16 *qkva, *qkvd, *z;
    __device__ __forceinline__ void operator()(const f32x4 (&acc)[2][2][4][2], const pg8::Unit& u, int wr, int wc, int fr, int fq) const {
        bf16* base; int ldc, colt; const int pn = u.pn;
        if (pn < 12) { base = qkva; ldc = 3072; colt = pn * 256; } else if (pn < 24) { base = qkvd; ldc = 3072; colt = (pn - 12) * 256; } else { base = z; ldc = 1024; colt = (pn - 24) * 256; }
        const int row0 = u.pm * 256 + wr * 64 + fr, col0 = colt + wc * 32 + 8 * fq;
#pragma unroll
        for (int ai = 0; ai < 2; ++ai)
#pragma unroll
            for (int m = 0; m < 4; ++m) { bf16* rowp = base + (size_t)(row0 + ai * 128 + m * 16) * ldc + col0;
#pragma unroll
                for (int bj = 0; bj < 2; ++bj) { const f32x4 v0 = acc[ai][bj][m][0], v1 = acc[ai][bj][m][1];
                    u32x4 w; w.x = pk2(v0[0], v0[1]); w.y = pk2(v0[2], v0[3]); w.z = pk2(v1[0], v1[1]); w.w = pk2(v1[2], v1[3]);
                    *(u32x4*)(rowp + bj * 128) = w; } }
    }
};
struct EpiBf16 {
    static constexpr bool PERM = true;
    bf16* O; int ldc;
    __device__ __forceinline__ void operator()(const f32x4 (&acc)[2][2][4][2], const pg8::Unit& u, int wr, int wc, int fr, int fq) const {
        const int row0 = u.pm * 256 + wr * 64 + fr, col0 = u.pn * 256 + wc * 32 + 8 * fq;
#pragma unroll
        for (int ai = 0; ai < 2; ++ai)
#pragma unroll
            for (int m = 0; m < 4; ++m) { bf16* rowp = O + (size_t)(row0 + ai * 128 + m * 16) * ldc + col0;
#pragma unroll
                for (int bj = 0; bj < 2; ++bj) { const f32x4 v0 = acc[ai][bj][m][0], v1 = acc[ai][bj][m][1];
                    u32x4 w; w.x = pk2(v0[0], v0[1]); w.y = pk2(v0[2], v0[3]); w.z = pk2(v1[0], v1[1]); w.w = pk2(v1[2], v1[3]);
                    *(u32x4*)(rowp + bj * 128) = w; } }
    }
};
struct EpiF32 {
    static constexpr bool PERM = false;
    float* C; int ldc;
    __device__ __forceinline__ void operator()(const f32x4 (&acc)[2][2][4][2], const pg8::Unit& u, int wr, int wc, int fr, int fq) const {
        const int row0 = u.pm * 256 + wr * 64 + fr, col0 = u.pn * 256 + wc * 32 + 4 * fq;
#pragma unroll
        for (int ai = 0; ai < 2; ++ai)
#pragma unroll
            for (int m = 0; m < 4; ++m) { float* rowp = C + (size_t)(row0 + ai * 128 + m * 16) * ldc + col0;
#pragma unroll
                for (int bj = 0; bj < 2; ++bj)
#pragma unroll
                    for (int n = 0; n < 2; ++n) *(f32x4*)(rowp + bj * 128 + n * 16) = acc[ai][bj][m][n]; }
    }
};
struct EpiResid {
    static constexpr bool PERM = false;
    const float* base; float* out; bf16* hb; float* ssq;
    __device__ __forceinline__ void operator()(const f32x4 (&acc)[2][2][4][2], const pg8::Unit& u, int wr, int wc, int fr, int fq) const {
        const int row0 = u.pm * 256 + wr * 64 + fr, col0 = u.pn * 256 + wc * 32 + 4 * fq;
#pragma unroll
        for (int ai = 0; ai < 2; ++ai)
#pragma unroll
            for (int m = 0; m < 4; ++m) { const int row = row0 + ai * 128 + m * 16; const size_t off = (size_t)row * 2048 + col0; float ss = 0.f;
#pragma unroll
                for (int bj = 0; bj < 2; ++bj)
#pragma unroll
                    for (int n = 0; n < 2; ++n) { const f32x4 b = *(const f32x4*)(base + off + bj * 128 + n * 16); const f32x4 o = b + acc[ai][bj][m][n];
                        *(f32x4*)(out + off + bj * 128 + n * 16) = o; ss += (o[0] * o[0] + o[1] * o[1]) + (o[2] * o[2] + o[3] * o[3]);
                        u32x2 w; w.x = pk2(o[0], o[1]); w.y = pk2(o[2], o[3]); *(u32x2*)(hb + off + bj * 128 + n * 16) = w; }
                ss += __shfl_xor(ss, 16); ss += __shfl_xor(ss, 32);
                if (fq == 0) ssq[(size_t)row * 32 + u.pn * 4 + wc] = ss; }
    }
};
struct EpiHid {
    static constexpr bool PERM = false;
    bf16* hid; const int* list; const float* rstd2;
    __device__ __forceinline__ void operator()(const f32x4 (&acc)[2][2][4][2], const pg8::Unit& u, int wr, int wc, int fr, int fq) const {
#pragma unroll
        for (int ai = 0; ai < 2; ++ai)
#pragma unroll
            for (int m = 0; m < 4; ++m) { const int r = ai * 128 + wr * 64 + m * 16 + fr, idx = u.roff + r;
                if (idx < u.cnt) { const int id = list[(size_t)u.e * 16384 + idx]; const float rs = rstd2[id >> 1];
                    bf16* rowp = hid + (size_t)(u.pm * 256 + r) * 512 + u.pn * 128 + wc * 16 + fq * 4;
#pragma unroll
                    for (int bj = 0; bj < 2; ++bj) { const f32x4 gt = acc[ai][bj][m][0] * rs, up = acc[ai][bj][m][1] * rs; f32x4 h;
#pragma unroll
                        for (int e = 0; e < 4; ++e) h[e] = gt[e] * __builtin_amdgcn_rcpf(1.f + __expf(-gt[e])) * up[e];
                        u32x2 w; w.x = pk2(h[0], h[1]); w.y = pk2(h[2], h[3]); *(u32x2*)(rowp + bj * 64) = w; } } }
    }
};
struct EpiDown {
    static constexpr bool PERM = true;
    bf16* Y; const int* list; const float* wgt;
    __device__ __forceinline__ void operator()(const f32x4 (&acc)[2][2][4][2], const pg8::Unit& u, int wr, int wc, int fr, int fq) const {
#pragma unroll
        for (int ai = 0; ai < 2; ++ai)
#pragma unroll
            for (int m = 0; m < 4; ++m) { const int r = ai * 128 + wr * 64 + m * 16 + fr, idx = u.roff + r;
                if (idx < u.cnt) { const int id = list[(size_t)u.e * 16384 + idx]; const float w8 = wgt[id];
                    bf16* rowp = Y + ((size_t)(id & 1) * S + (id >> 1)) * 2048 + u.pn * 256 + wc * 32 + 8 * fq;
#pragma unroll
                    for (int bj = 0; bj < 2; ++bj) { const f32x4 v0 = acc[ai][bj][m][0] * w8, v1 = acc[ai][bj][m][1] * w8;
                        u32x4 w; w.x = pk2(v0[0], v0[1]); w.y = pk2(v0[2], v0[3]); w.z = pk2(v1[0], v1[1]); w.w = pk2(v1[2], v1[3]);
                        *(u32x4*)(rowp + bj * 128) = w; } } }
    }
};

#define XB_TMO      128
#define XB_XCNT(j)  (256  + 64 * (j))
#define XB_XSUB(j)  (1280 + 64 * (j))
#define XB_XGEN(j)  (2304 + 64 * (j))
#define XB_TOP      3328
#define XB_TOPGEN   3392
#define XCD_BAR_WORDS 3456
#define XB_SPIN_CAP (1u << 18)
__device__ __forceinline__ unsigned xb_ld(unsigned* p)              { return __hip_atomic_load(p, __ATOMIC_RELAXED, __HIP_MEMORY_SCOPE_AGENT); }
__device__ __forceinline__ unsigned xb_add(unsigned* p, unsigned v) { return __hip_atomic_fetch_add(p, v, __ATOMIC_RELAXED, __HIP_MEMORY_SCOPE_AGENT); }
__device__ __forceinline__ unsigned xb_xcc_id() { return (unsigned)__builtin_amdgcn_s_getreg((3 << 11) | 20) & 0xFu; }
#define XB_SPIN(cond, bar) do { unsigned _sp = 0; while (cond) { __builtin_amdgcn_s_sleep(1); \
    if ((++_sp & 255u) == 0u) { if (xb_ld(&(bar)[XB_TMO])) break; if (_sp > XB_SPIN_CAP) { atomicAdd(&(bar)[XB_TMO], 1u); break; } } } } while (0)
struct XcdBarrier { unsigned* bar; unsigned x; volatile LAS unsigned* st; };
__device__ __forceinline__ XcdBarrier xcd_barrier_post(unsigned* bar, volatile LAS unsigned* st) {
    XcdBarrier b; b.bar = bar; b.x = xb_xcc_id(); b.st = st;
    if (threadIdx.x == 0) (void)xb_add(&bar[XB_XCNT(b.x)], 1u);
    return b;
}
__device__ __forceinline__ void xcd_barrier_complete(unsigned* bar, unsigned x, unsigned& nloc, unsigned& nx) {
    const unsigned G = gridDim.x * gridDim.y * gridDim.z;
    unsigned sum, cnt, mine, sp = 0u;
    for (;;) {
        sum = 0u; cnt = 0u; mine = 0u;
#pragma unroll
        for (unsigned j = 0; j < 16; ++j) { const unsigned c = xb_ld(&bar[XB_XCNT(j)]); sum += c; cnt += (c > 0u) ? 1u : 0u; mine = (j == x) ? c : mine; }
        if (sum == G) break;
        __builtin_amdgcn_s_sleep(1);
        if ((++sp & 255u) == 0u) { if (xb_ld(&bar[XB_TMO])) break; if (sp > XB_SPIN_CAP) { atomicAdd(&bar[XB_TMO], 1u); break; } }
    }
    nloc = mine > 0u ? mine : 1u; nx = cnt > 0u ? cnt : 1u;
}
__device__ __forceinline__ void xcd_barrier(const XcdBarrier& b) {
    asm volatile("s_waitcnt vmcnt(0)" ::: "memory");
    __syncthreads();
    if (threadIdx.x == 0) {
        unsigned* bar = b.bar;
        __builtin_amdgcn_s_waitcnt(0);
        unsigned nloc = b.st[0], nx = b.st[1];
        if (nloc == 0u) { xcd_barrier_complete(bar, b.x, nloc, nx); b.st[0] = nloc; b.st[1] = nx; }
        const unsigned old = xb_add(&bar[XB_XSUB(b.x)], 1u);
        const unsigned gen = old / nloc;
        if (old + 1u == (gen + 1u) * nloc) {
            __builtin_amdgcn_fence(__ATOMIC_RELEASE, "agent");
            asm volatile("s_waitcnt vmcnt(0)" ::: "memory");
            const unsigned og = xb_add(&bar[XB_TOP], 1u);
            const unsigned tg = og / nx;
            if (og + 1u == (tg + 1u) * nx) xb_add(&bar[XB_TOPGEN], 1u);
            else XB_SPIN(xb_ld(&bar[XB_TOPGEN]) == tg, bar);
            __builtin_amdgcn_fence(__ATOMIC_ACQUIRE, "agent");
            xb_add(&bar[XB_XGEN(b.x)], 1u);
            asm volatile("s_waitcnt vmcnt(0)" ::: "memory");
        } else {
            XB_SPIN(xb_ld(&bar[XB_XGEN(b.x)]) == gen, bar);
            __builtin_amdgcn_fence(__ATOMIC_ACQUIRE, "agent");
            asm volatile("s_waitcnt vmcnt(0)" ::: "memory");
        }
    }
    __syncthreads();
}

struct Frame {
    LAS unsigned char* lds;
    int tid, lane, wave, vcu, G;
    const float* in[24]; float* out; unsigned char* ws;
};
#define IN_X 0
#define IN_MEM 1
#define IN_GMIX 2
#define IN_WIN 3
#define IN_CONVW 4
#define IN_ALOG 5
#define IN_DTB 6
#define IN_GDOUT 7
#define IN_GAOUT 8
#define IN_WOUT 9
#define IN_GCROSS 10
#define IN_GMEM 11
#define IN_WQ 12
#define IN_WKV 13
#define IN_WO 14
#define IN_GMOE 15
#define IN_WGROUP 16
#define IN_BGROUP 17
#define IN_WEXPERT 18
#define IN_BEXPERT 19
#define IN_WGATE 20
#define IN_WUP 21
#define IN_WDOWN 22
#define IN_GFINAL 23
template <bool RMAP>
__device__ __forceinline__ void p0_transpose_item(const float* W, int ldw, int k0, int n0, bf16* WT, int ldt, int drow0, const float* gain, LAS float* scr, int lane) {
#pragma unroll 8
    for (int i = 0; i < 32; ++i) { const int kk = 2 * i + (lane >> 5); scr[kk * 33 + (lane & 31)] = W[(size_t)(k0 + kk) * ldw + n0 + (lane & 31)]; }
    asm volatile("s_waitcnt lgkmcnt(0)" ::: "memory");
    const int c = lane & 7;
    float g8[8];
#pragma unroll
    for (int e = 0; e < 8; ++e) g8[e] = gain ? gain[k0 + 8 * c + e] : 1.f;
#pragma unroll
    for (int j = 0; j < 4; ++j) { const int n = (lane >> 3) + 8 * j; const LAS float* s = scr + (8 * c) * 33 + n;
        u32x4 o; o.x = pk2(s[0 * 33] * g8[0], s[1 * 33] * g8[1]); o.y = pk2(s[2 * 33] * g8[2], s[3 * 33] * g8[3]); o.z = pk2(s[4 * 33] * g8[4], s[5 * 33] * g8[5]); o.w = pk2(s[6 * 33] * g8[6], s[7 * 33] * g8[7]);
        const int dr = drow0 + (RMAP ? (32 * (n >> 4) + (n & 15)) : n);
        *(u32x4*)(WT + (size_t)dr * ldt + k0 + 8 * c) = o; }
    asm volatile("s_waitcnt lgkmcnt(0)" ::: "memory");
}

__device__ __forceinline__ void p0_prologue(Frame& F) {
    unsigned char* ws = F.ws;
    const int gw = F.vcu * 8 + F.wave, NGW = F.G * 8;
    {
        LAS float* T = (LAS float*)F.lds;
        const float* win = F.in[IN_WIN];
        for (int k = F.tid; k < D; k += 512) {
            const f32x4* src = (const f32x4*)(win + (size_t)k * LDWIN + NPROJ);
            const f32x4 a = src[0], b = src[1], c = src[2], d = src[3];
            T[0 * D + k] = a[0]; T[1 * D + k] = a[1]; T[2 * D + k] = a[2]; T[3 * D + k] = a[3];
            T[4 * D + k] = b[0]; T[5 * D + k] = b[1]; T[6 * D + k] = b[2]; T[7 * D + k] = b[3];
            T[8 * D + k] = c[0]; T[9 * D + k] = c[1]; T[10 * D + k] = c[2]; T[11 * D + k] = c[3];
            T[12 * D + k] = d[0]; T[13 * D + k] = d[1]; T[14 * D + k] = d[2]; T[15 * D + k] = d[3];
        }
        __syncthreads();
        const float* gm = F.in[IN_GMIX]; bf16* XN = (bf16*)(ws + WS_XN); float* BA = (float*)(ws + WS_BA);
        f32x4 gv[8];
#pragma unroll
        for (int j = 0; j < 8; ++j) gv[j] = *(const f32x4*)(gm + 4 * F.lane + 256 * j);
        for (int row = gw; row < S; row += NGW) {
            const float* xr = F.in[IN_X] + (size_t)row * D;
            f32x4 v[8]; float ss = 0.f;
#pragma unroll
            for (int j = 0; j < 8; ++j) { v[j] = *(const f32x4*)(xr + 4 * F.lane + 256 * j); ss += (v[j][0] * v[j][0] + v[j][1] * v[j][1]) + (v[j][2] * v[j][2] + v[j][3] * v[j][3]); }
            const float rstd = __builtin_amdgcn_rsqf(wave_sum(ss) * (1.f / D) + EPS);
#pragma unroll
            for (int j = 0; j < 8; ++j) { v[j] = v[j] * rstd * gv[j]; u32x2 w; w.x = pk2(v[j][0], v[j][1]); w.y = pk2(v[j][2], v[j][3]); *(u32x2*)(XN + (size_t)row * D + 4 * F.lane + 256 * j) = w; }
            float myo = 0.f;
#pragma unroll 1
            for (int o = 0; o < 16; ++o) { float a = 0.f;
#pragma unroll
                for (int j = 0; j < 8; ++j) { const f32x4 t = *(const LAS f32x4*)(T + o * D + 4 * F.lane + 256 * j); a += (v[j][0] * t[0] + v[j][1] * t[1]) + (v[j][2] * t[2] + v[j][3] * t[3]); }
                a = wave_sum(a); if (F.lane == o) myo = a; }
            if (F.lane < 16) BA[(size_t)row * 16 + F.lane] = myo;
        }
        __syncthreads();
    }
    {
        const float* gm = F.in[IN_GMEM]; bf16* MEMN = (bf16*)(ws + WS_MEMN);
        for (int row = gw; row < NMEM; row += NGW) {
            const float* xr = F.in[IN_MEM] + (size_t)row * D;
            f32x4 v[8]; float ss = 0.f;
#pragma unroll
            for (int j = 0; j < 8; ++j) { v[j] = *(const f32x4*)(xr + 4 * F.lane + 256 * j); ss += (v[j][0] * v[j][0] + v[j][1] * v[j][1]) + (v[j][2] * v[j][2] + v[j][3] * v[j][3]); }
            const float rstd = __builtin_amdgcn_rsqf(wave_sum(ss) * (1.f / D) + EPS);
#pragma unroll
            for (int j = 0; j < 8; ++j) { const f32x4 g = *(const f32x4*)(gm + 4 * F.lane + 256 * j); const f32x4 o = v[j] * rstd * g; u32x2 w; w.x = pk2(o[0], o[1]); w.y = pk2(o[2], o[3]); *(u32x2*)(MEMN + (size_t)row * D + 4 * F.lane + 256 * j) = w; }
        }
    }
    {
        bf16* WR = (bf16*)(ws + WS_WR); const float* gmoe = F.in[IN_GMOE]; const float* wg = F.in[IN_WGROUP]; const float* we = F.in[IN_WEXPERT];
        for (int idx = F.vcu * 512 + F.tid; idx < 256 * 256; idx += F.G * 512) { const int n = idx >> 8, k = (idx & 255) * 8; float v[8];
#pragma unroll
            for (int e = 0; e < 8; ++e) { float w = 0.f; if (n < 8) w = wg[(size_t)(k + e) * 8 + n]; else if (n < 72) w = we[(size_t)(k + e) * 64 + (n - 8)]; v[e] = w * gmoe[k + e]; }
            u32x4 o; o.x = pk2(v[0], v[1]); o.y = pk2(v[2], v[3]); o.z = pk2(v[4], v[5]); o.w = pk2(v[6], v[7]);
            *(u32x4*)(WR + (size_t)n * D + k) = o; }
    }
    {
        LAS float* scr = (LAS float*)(F.lds + F.wave * 16384);
        constexpr int I_IN = 32 * 224, I_OUT = 32 * 64, I_Q = 32 * 16, I_KV = 32 * 32, I_O = 8 * 64, I_E = 512;
        constexpr int NDENSE = I_IN + I_OUT + I_Q + I_KV + I_O, NITEMS = NDENSE + NEXP * 3 * I_E;
        for (int it = gw; it < NITEMS; it += NGW) {
            int r = it;
            if (r < I_IN) { p0_transpose_item<false>(F.in[IN_WIN], LDWIN, 64 * (r / 224), 32 * (r % 224), (bf16*)(ws + WS_WIN), D, 32 * (r % 224), nullptr, scr, F.lane); continue; } r -= I_IN;
            if (r < I_OUT) { p0_transpose_item<false>(F.in[IN_WOUT], D, 64 * (r / 64), 32 * (r % 64), (bf16*)(ws + WS_WOUT), D, 32 * (r % 64), nullptr, scr, F.lane); continue; } r -= I_OUT;
            if (r < I_Q) { p0_transpose_item<false>(F.in[IN_WQ], 512, 64 * (r / 16), 32 * (r % 16), (bf16*)(ws + WS_WQ), D, 32 * (r % 16), F.in[IN_GCROSS], scr, F.lane); continue; } r -= I_Q;
            if (r < I_KV) { p0_transpose_item<false>(F.in[IN_WKV], 1024, 64 * (r / 32), 32 * (r % 32), (bf16*)(ws + WS_WKV), D, 32 * (r % 32), nullptr, scr, F.lane); continue; } r -= I_KV;
            if (r < I_O) { p0_transpose_item<false>(F.in[IN_WO], D, 64 * (r / 64), 32 * (r % 64), (bf16*)(ws + WS_WO), 512, 32 * (r % 64), nullptr, scr, F.lane); continue; } r -= I_O;
            const int e = r / (3 * I_E), q = r % (3 * I_E), which = q / I_E, ii = q % I_E;
            if (which == 0) { p0_transpose_item<true>(F.in[IN_WGATE] + (size_t)e * D * DE, DE, 64 * (ii / 16), 32 * (ii % 16), (bf16*)(ws + WS_WGU) + (size_t)e * 1024 * D, D, 64 * (ii % 16), F.in[IN_GMOE], scr, F.lane); }
            else if (which == 1) { p0_transpose_item<true>(F.in[IN_WUP] + (size_t)e * D * DE, DE, 64 * (ii / 16), 32 * (ii % 16), (bf16*)(ws + WS_WGU) + (size_t)e * 1024 * D, D, 64 * (ii % 16) + 16, F.in[IN_GMOE], scr, F.lane); }
            else { p0_transpose_item<false>(F.in[IN_WDOWN] + (size_t)e * DE * D, D, 64 * (ii / 64), 32 * (ii % 64), (bf16*)(ws + WS_WD) + (size_t)e * D * DE, DE, 32 * (ii % 64), nullptr, scr, F.lane); }
        }
    }
}
#define MFMA32(a, b, c) __builtin_amdgcn_mfma_f32_32x32x16_bf16((a), (b), (c), 0, 0, 0)
#define MFMA16(a, b, c) __builtin_amdgcn_mfma_f32_16x16x32_bf16((a), (b), (c), 0, 0, 0)
typedef short v4i16_t __attribute__((ext_vector_type(4)));
__device__ __forceinline__ unsigned offb(unsigned row, unsigned ch) { return 256u * row + 16u * (ch ^ (((row & 3u) << 2) | ((row >> 2) & 3u))); }
__device__ __forceinline__ unsigned off128(unsigned row, unsigned ch) { return 128u * row + 16u * (ch ^ (row & 7u)); }
__device__ __forceinline__ int crow(int r, int h) { return (r & 3) + 8 * (r >> 2) + 4 * h; }
__device__ __forceinline__ s16x4 vtr(const LAS unsigned char* p) { return __builtin_bit_cast(s16x4, __builtin_amdgcn_ds_read_tr16_b64_v4i16((LAS v4i16_t*)p)); }

template <int MODE>
__device__ __forceinline__ void attn_wave(LAS unsigned char* wl, int lane, const bf16* qrow0, long qstride, const bf16* kbase, const bf16* vbase, long kvstride,
                                          int k_first, int ntiles, float c1, float b2, float rq, bf16* orow0, long ostride, float* lse0, long lsestride) {
    const int c = lane & 31, h = lane >> 5;
    bf16x8 qf[8];
#pragma unroll
    for (int s = 0; s < 8; ++s) qf[s] = *(const bf16x8*)(qrow0 + (long)c * qstride + 16 * s + 8 * h);
    f32x16 O[4];
#pragma unroll
    for (int dt = 0; dt < 4; ++dt)
#pragma unroll
        for (int i = 0; i < 16; ++i) O[dt][i] = 0.f;
    float m = -1e30f, l = 0.f;
    const int q4 = (lane & 15) >> 2, p4 = lane & 3, blk = (lane >> 4) & 1;
    for (int t = 0; t < ntiles; ++t) {
        const int kt = k_first + 32 * t;
        if (kt < 0) continue;
#pragma unroll
        for (int i = 0; i < 8; ++i) { const int n = lane + 64 * i, row = n >> 4, ch = n & 15;
            const u32x4 kv = *(const u32x4*)(kbase + (long)(kt + row) * kvstride + ch * 8);
            const u32x4 vv = *(const u32x4*)(vbase + (long)(kt + row) * kvstride + ch * 8);
            *(LAS u32x4*)(wl + offb(row, ch)) = kv; *(LAS u32x4*)(wl + 8192 + offb(row, ch)) = vv; }
        asm volatile("s_waitcnt lgkmcnt(0)" ::: "memory");
        f32x16 acc;
#pragma unroll
        for (int i = 0; i < 16; ++i) acc[i] = 0.f;
#pragma unroll
        for (int s = 0; s < 8; ++s) { const bf16x8 kf = *(const LAS bf16x8*)(wl + offb(c, 2 * s + h)); acc = MFMA32(kf, qf[s], acc); }
        float tmax = -__builtin_inff();
        if (MODE == 0) { const int dbase = 128 - 32 * t + c;
#pragma unroll
            for (int i = 0; i < 16; ++i) { const int dist = dbase - crow(i, h); float sc = acc[i] * c1 - b2 * (float)dist; if ((unsigned)dist > 128u) sc = -__builtin_inff(); acc[i] = sc; tmax = fmaxf(tmax, sc); }
        } else { const float cc = c1 * rq;
#pragma unroll
            for (int i = 0; i < 16; ++i) { const float sc = acc[i] * cc; acc[i] = sc; tmax = fmaxf(tmax, sc); }
        }
        tmax = fmaxf(tmax, __shfl_xor(tmax, 32));
        const float mn = fmaxf(m, tmax), alpha = __builtin_amdgcn_exp2f(m - mn);
        float rs = 0.f;
#pragma unroll
        for (int i = 0; i < 16; ++i) { acc[i] = __builtin_amdgcn_exp2f(acc[i] - mn); rs += acc[i]; }
        rs += __shfl_xor(rs, 32);
        l = l * alpha + rs; m = mn;
#pragma unroll
        for (int dt = 0; dt < 4; ++dt)
#pragma unroll
            for (int i = 0; i < 16; ++i) O[dt][i] *= alpha;
        bf16x8 pf[2];
#pragma unroll
        for (int ks = 0; ks < 2; ++ks) { u32x4 w = {pk2(acc[8 * ks + 0], acc[8 * ks + 1]), pk2(acc[8 * ks + 2], acc[8 * ks + 3]), pk2(acc[8 * ks + 4], acc[8 * ks + 5]), pk2(acc[8 * ks + 6], acc[8 * ks + 7])}; pf[ks] = __builtin_bit_cast(bf16x8, w); }
#pragma unroll
        for (int dt = 0; dt < 4; ++dt)
#pragma unroll
            for (int ks = 0; ks < 2; ++ks) {
                const s16x4 lo = vtr(wl + 8192 + offb(16 * ks + 4 * h + q4, 4 * dt + 2 * blk + (p4 >> 1)) + 8 * (p4 & 1));
                const s16x4 hi = vtr(wl + 8192 + offb(16 * ks + 8 + 4 * h + q4, 4 * dt + 2 * blk + (p4 >> 1)) + 8 * (p4 & 1));
                const bf16x8 vf = __builtin_shufflevector(lo, hi, 0, 1, 2, 3, 4, 5, 6, 7);
                O[dt] = MFMA32(vf, pf[ks], O[dt]);
            }
    }
    const float inv = 1.f / l;
#pragma unroll
    for (int dt = 0; dt < 4; ++dt)
#pragma unroll
        for (int g = 0; g < 4; ++g) { u32x2 w; w.x = pk2(O[dt][4 * g] * inv, O[dt][4 * g + 1] * inv); w.y = pk2(O[dt][4 * g + 2] * inv, O[dt][4 * g + 3] * inv);
            *(u32x2*)(orow0 + (long)c * ostride + 32 * dt + 8 * g + 4 * h) = w; }
    if (MODE == 0) { if (h == 0) lse0[(long)c * lsestride] = (m + __builtin_amdgcn_logf(l)) * LN2; }
}

__device__ __forceinline__ void dilated_unit(Frame& F, int wu) {
    const int pat = wu >> 12, hd = (wu >> 9) & 7, blkq = wu & 511;
    const int d = pat == 0 ? 1 : (pat == 1 ? 4 : 16), L = S / d, nbq = L / 32;
    const int res = blkq / nbq, q0 = (blkq % nbq) * 32;
    const bf16* QKVA = (const bf16*)(F.ws + WS_QKVA);
    const long rs_ = (long)d * 3072;
    const bf16* base = QKVA + (long)res * 3072 + hd * 128;
    const float slope = __builtin_amdgcn_exp2f(-(float)(hd + 1));
    bf16* AO = (bf16*)(F.ws + WS_ATTO) + (size_t)pat * S * 1024 + (long)res * 1024 + hd * 128;
    float* LSE = (float*)(F.ws + WS_LSE) + (size_t)pat * S * 8 + (long)res * 8 + hd;
    attn_wave<0>(F.lds + F.wave * WAVE_LDS, F.lane, base + (long)q0 * rs_, rs_, base + 1024, base + 2048, rs_, q0 - 128, 5,
                 0.08838834764831845f * LOG2E, slope * (float)d * LOG2E, 1.f, AO + (long)q0 * d * 1024, (long)d * 1024, LSE + (long)q0 * d * 8, (long)d * 8);
}

__device__ __forceinline__ void cross_unit(Frame& F, int unit) {
    const int panel = unit >> 2, hd = unit & 3, row0 = panel * 256 + F.wave * 32;
    const bf16* QM = (const bf16*)(F.ws + WS_QMEM); const bf16* KV = (const bf16*)(F.ws + WS_KVMEM); const float* SSQ = (const float*)(F.ws + WS_SSQ1);
    const int qrow = row0 + (F.lane & 31);
    float ss = 0.f;
#pragma unroll
    for (int i = 0; i < 8; ++i) { const f32x4 v = *(const f32x4*)(SSQ + (size_t)qrow * 32 + 4 * i); ss += (v[0] + v[1]) + (v[2] + v[3]); }
    const float rq = __builtin_amdgcn_rsqf(ss * (1.f / D) + EPS);
    attn_wave<1>(F.lds + F.wave * WAVE_LDS, F.lane, QM + (size_t)row0 * 512 + hd * 128, 512, KV + hd * 128, KV + 512 + hd * 128, 1024, 0, 8,
                 0.08838834764831845f * LOG2E, 0.f, rq, (bf16*)(F.ws + WS_OMEM) + (size_t)row0 * 512 + hd * 128, 512, nullptr, 0);
}

__device__ __forceinline__ void merge_token(Frame& F, int t) {
    const int lane = F.lane, hd = lane >> 3, col = lane * 16;
    const bf16* AO = (const bf16*)(F.ws + WS_ATTO); const float* LSE = (const float*)(F.ws + WS_LSE);
    bf16* MIX = (bf16*)(F.ws + WS_MIX);
    float l0 = LSE[(size_t)t * 8 + hd], l1 = LSE[(size_t)S * 8 + (size_t)t * 8 + hd], l2 = LSE[(size_t)2 * S * 8 + (size_t)t * 8 + hd];
    const float mx = fmaxf(l0, fmaxf(l1, l2));
    float w0 = __expf(l0 - mx), w1 = __expf(l1 - mx), w2 = __expf(l2 - mx); const float wi = 1.f / (w0 + w1 + w2); w0 *= wi; w1 *= wi; w2 *= wi;
    float a[16]; float ss = 0.f;
#pragma unroll
    for (int hlf = 0; hlf < 2; ++hlf) {
        const bf16x8 o0 = *(const bf16x8*)(AO + (size_t)t * 1024 + col + 8 * hlf), o1 = *(const bf16x8*)(AO + ((size_t)S + t) * 1024 + col + 8 * hlf), o2 = *(const bf16x8*)(AO + ((size_t)2 * S + t) * 1024 + col + 8 * hlf);
#pragma unroll
        for (int e = 0; e < 8; ++e) { const float v = w0 * bf2f((unsigned short)o0[e]) + w1 * bf2f((unsigned short)o1[e]) + w2 * bf2f((unsigned short)o2[e]); a[8 * hlf + e] = v; ss += v * v; }
    }
    const float rstd = __builtin_amdgcn_rsqf(wave_sum(ss) * (1.f / 1024.f) + EPS);
    const float* ga = F.in[IN_GAOUT];
    {
        u32x4 w0_, w1_; float g[16];
#pragma unroll
        for (int e = 0; e < 16; e += 4) { const f32x4 gg = *(const f32x4*)(ga + col + e); g[e] = gg[0]; g[e + 1] = gg[1]; g[e + 2] = gg[2]; g[e + 3] = gg[3]; }
        w0_.x = pk2(a[0] * rstd * g[0], a[1] * rstd * g[1]); w0_.y = pk2(a[2] * rstd * g[2], a[3] * rstd * g[3]); w0_.z = pk2(a[4] * rstd * g[4], a[5] * rstd * g[5]); w0_.w = pk2(a[6] * rstd * g[6], a[7] * rstd * g[7]);
        w1_.x = pk2(a[8] * rstd * g[8], a[9] * rstd * g[9]); w1_.y = pk2(a[10] * rstd * g[10], a[11] * rstd * g[11]); w1_.z = pk2(a[12] * rstd * g[12], a[13] * rstd * g[13]); w1_.w = pk2(a[14] * rstd * g[14], a[15] * rstd * g[15]);
        *(u32x4*)(MIX + (size_t)t * 2048 + col) = w0_; *(u32x4*)(MIX + (size_t)t * 2048 + col + 8) = w1_;
    }
    const float* OD = (const float*)(F.ws + WS_ODELTA); const bf16* Z = (const bf16*)(F.ws + WS_Z); const float* gd = F.in[IN_GDOUT];
    float o[16]; float s2 = 0.f;
#pragma unroll
    for (int e = 0; e < 16; e += 4) { const f32x4 v = *(const f32x4*)(OD + (size_t)t * 1024 + col + e); o[e] = v[0]; o[e + 1] = v[1]; o[e + 2] = v[2]; o[e + 3] = v[3]; s2 += (v[0] * v[0] + v[1] * v[1]) + (v[2] * v[2] + v[3] * v[3]); }
    s2 += __shfl_xor(s2, 1); s2 += __shfl_xor(s2, 2); s2 += __shfl_xor(s2, 4);
    const float rd = __builtin_amdgcn_rsqf(s2 * (1.f / 128.f) + EPS);
    const int dcol = col & 127;
    float r[16];
#pragma unroll
    for (int hlf = 0; hlf < 2; ++hlf) { const bf16x8 zz = *(const bf16x8*)(Z + (size_t)t * 1024 + col + 8 * hlf);
#pragma unroll
        for (int e = 0; e < 8; ++e) { const float zv = bf2f((unsigned short)zz[e]); const float sz = zv * __builtin_amdgcn_rcpf(1.f + __expf(-zv)); r[8 * hlf + e] = o[8 * hlf + e] * rd * gd[dcol + 8 * hlf + e] * sz; } }
    u32x4 x0, x1;
    x0.x = pk2(r[0], r[1]); x0.y = pk2(r[2], r[3]); x0.z = pk2(r[4], r[5]); x0.w = pk2(r[6], r[7]);
    x1.x = pk2(r[8], r[9]); x1.y = pk2(r[10], r[11]); x1.z = pk2(r[12], r[13]); x1.w = pk2(r[14], r[15]);
    *(u32x4*)(MIX + (size_t)t * 2048 + 1024 + col) = x0; *(u32x4*)(MIX + (size_t)t * 2048 + 1024 + col + 8) = x1;
}
__device__ __forceinline__ int perm32pos(int x) { return (x & ~31) + 8 * ((x >> 2) & 3) + 4 * ((x >> 4) & 1) + (x & 3); }

template <class Fn>
__device__ __forceinline__ void conv_col(const bf16* src, int t0, const float* cw  , Fn&& fn) {
    const float w0 = cw[0], w1 = cw[3072], w2 = cw[2 * 3072], w3 = cw[3 * 3072];
    float xm3 = 0.f, xm2 = 0.f, xm1 = 0.f;
    if (t0 > 0) { xm3 = bf2f(src[-3 * 3072]); xm2 = bf2f(src[-2 * 3072]); xm1 = bf2f(src[-1 * 3072]); }
    const bf16* p = src;
#pragma unroll
    for (int c = 0; c < 64; ++c) { const float xc = bf2f(*p); p += 3072; asm volatile("" : "+v"(p));
        const float v = (w0 * xm3 + w1 * xm2) + (w2 * xm1 + w3 * xc);
        fn(c, v * __builtin_amdgcn_rcpf(1.f + __expf(-v))); xm3 = xm2; xm2 = xm1; xm1 = xc; }
}

__device__ __forceinline__ void delta_prep_unit(Frame& F, int cu) {
    const int chunk = cu >> 3, hd = cu & 7, t0 = chunk * 64, lane = F.lane;
    LAS unsigned char* wl = F.lds + F.wave * WAVE_LDS;
    LAS unsigned char* wsm = F.lds + PREP_SMALL_OFF + F.wave * 1280;
    LAS float* Am = (LAS float*)wl; LAS float* gcs = (LAS float*)(wsm); LAS float* betas = (LAS float*)(wsm + 256); LAS float* rks = (LAS float*)(wsm + 512); LAS float* rqs = (LAS float*)(wsm + 768);
    unsigned char* ws = F.ws;
    const bf16* QKVD = (const bf16*)(ws + WS_QKVD); const float* BA = (const float*)(ws + WS_BA); const float* cw = F.in[IN_CONVW];
    bf16* QN = (bf16*)(ws + WS_QN); bf16* KN = (bf16*)(ws + WS_KN); bf16* QDEC = (bf16*)(ws + WS_QDEC); bf16* KDT = (bf16*)(ws + WS_KDT); bf16* WW = (bf16*)(ws + WS_WW);
    float* UT = (float*)(ws + WS_UT); bf16* QKM = (bf16*)(ws + WS_QKM); float* GLAST = (float*)(ws + WS_GLAST);
    float glast;
    {
        const float a = BA[(size_t)(t0 + lane) * 16 + 8 + hd], b = BA[(size_t)(t0 + lane) * 16 + hd];
        const float beta = 1.f / (1.f + __expf(-b));
        const float x = a + F.in[IN_DTB][hd]; const float sp = x > 20.f ? x : log1pf(__expf(x));
        float gc = -__expf(F.in[IN_ALOG][hd]) * sp;
#pragma unroll
        for (int o = 1; o < 64; o <<= 1) { const float t = __shfl_up(gc, o); if (lane >= o) gc += t; }
        glast = __shfl(gc, 63);
        gcs[lane] = gc; betas[lane] = beta;
        if (lane == 0) GLAST[cu] = glast;
    }
#ifndef PREP_PARTS
#define PREP_PARTS 15
#endif
    if (PREP_PARTS & 1) {
#pragma unroll 1
    for (int sec = 0; sec < 2; ++sec) {
        float ss[64];
#pragma unroll
        for (int c = 0; c < 64; ++c) ss[c] = 0.f;
#pragma unroll 1
        for (int hh = 0; hh < 2; ++hh) { const int col = sec * 1024 + hd * 128 + 64 * hh + lane;
            conv_col(QKVD + (size_t)t0 * 3072 + col, t0, cw + col, [&](int c, float y) { ss[c] += y * y; }); }
        float myr = 0.f;
#pragma unroll
        for (int c = 0; c < 64; ++c) { const float tot = wave_sum(ss[c]); if (lane == c) myr = __builtin_amdgcn_rsqf(tot + EPS); }
        if (sec == 0) rqs[lane] = myr; else rks[lane] = myr;
    }
    }
    asm volatile("s_waitcnt lgkmcnt(0)" ::: "memory");
    if (PREP_PARTS & 2) {
#pragma unroll 1
    for (int hh = 0; hh < 2; ++hh) {
        const int j = 64 * hh + lane;
        { const int col = hd * 128 + j; const int pj = hd * 128 + perm32pos(j);
          bf16* pq = QN + (size_t)t0 * 1024 + hd * 128 + j; bf16* pd = QDEC + (size_t)t0 * 1024 + pj;
          conv_col(QKVD + (size_t)t0 * 3072 + col, t0, cw + col, [&](int c, float y) { const float qn = y * rqs[c];
              *pq = (bf16)(pk2(qn, 0.f) & 0xffffu); *pd = (bf16)(pk2(qn * 0.08838834764831845f * __expf(gcs[c]), 0.f) & 0xffffu);
              pq += 1024; pd += 1024; asm volatile("" : "+v"(pq), "+v"(pd)); }); }
        { const int col = 1024 + hd * 128 + j; unsigned kdw[32]; float kprev = 0.f;
          bf16* pk = KN + (size_t)t0 * 1024 + hd * 128 + j;
          conv_col(QKVD + (size_t)t0 * 3072 + col, t0, cw + col, [&](int c, float y) { const float kn = y * rks[c];
              *pk = (bf16)(pk2(kn, 0.f) & 0xffffu); pk += 1024; asm volatile("" : "+v"(pk));
              const float kd = kn * __expf(glast - gcs[c]);
              if (c & 1) kdw[perm32pos(c - 1) >> 1] = pk2(kprev, kd); else kprev = kd; });
          u32x4* dst = (u32x4*)(KDT + ((size_t)cu * 128 + j) * 64);
#pragma unroll
          for (int q = 0; q < 8; ++q) dst[q] = (u32x4){kdw[4 * q], kdw[4 * q + 1], kdw[4 * q + 2], kdw[4 * q + 3]}; }
    }
    }
    asm volatile("s_waitcnt vmcnt(0)" ::: "memory");
    if (PREP_PARTS & 4) {
    {
        const int r = lane & 31, h = lane >> 5;
        const int pl = 8 * ((r >> 2) & 3) + 4 * (r >> 4) + (r & 3);
        const bf16* knb = KN + (size_t)(t0 + r) * 1024 + hd * 128 + 8 * h; const bf16* qnb = QN + (size_t)(t0 + r) * 1024 + hd * 128 + 8 * h;
#pragma unroll 1
        for (int tile = 0; tile < 3; ++tile) { const int I = tile > 0 ? 1 : 0, J = tile > 1 ? 1 : 0;
            f32x16 ak, aq;
#pragma unroll
            for (int i = 0; i < 16; ++i) { ak[i] = 0.f; aq[i] = 0.f; }
#pragma unroll
            for (int s = 0; s < 8; ++s) { const bf16x8 kI = *(const bf16x8*)(knb + (size_t)I * 32 * 1024 + 16 * s), kJ = *(const bf16x8*)(knb + (size_t)J * 32 * 1024 + 16 * s), qI = *(const bf16x8*)(qnb + (size_t)I * 32 * 1024 + 16 * s);
                ak = MFMA32(kI, kJ, ak); aq = MFMA32(qI, kJ, aq); }
            const int sc = 32 * J + r; const float gs = gcs[sc];
#pragma unroll
            for (int i = 0; i < 16; ++i) { const int c = 32 * I + crow(i, h); const float dec = __expf(fminf(gcs[c] - gs, 0.f));
                Am[c * 64 + sc] = ak[i] * betas[c] * dec;
                const float qv = (sc <= c) ? aq[i] * 0.08838834764831845f * dec : 0.f;
                QKM[(size_t)cu * 4096 + c * 64 + 32 * J + pl] = (bf16)(pk2(qv, 0.f) & 0xffffu); }
        }
#pragma unroll
        for (int i = 0; i < 16; ++i) QKM[(size_t)cu * 4096 + crow(i, h) * 64 + 32 + pl] = (bf16)0;
    }
    }
    asm volatile("s_waitcnt lgkmcnt(0)" ::: "memory");
    if (PREP_PARTS & 8) {
#pragma unroll 1
    for (int pass = 0; pass < 4; ++pass) {
        const int hh = pass & 1, j = 64 * hh + lane; float x[64];
        if (pass < 2) { const int col = 2048 + hd * 128 + j; conv_col(QKVD + (size_t)t0 * 3072 + col, t0, cw + col, [&](int c, float y) { x[c] = y * betas[c]; });
        } else { const bf16* pk = KN + (size_t)t0 * 1024 + hd * 128 + j;
#pragma unroll
            for (int c = 0; c < 64; ++c) { x[c] = bf2f(*pk) * betas[c] * __expf(gcs[c]); pk += 1024; asm volatile("" : "+v"(pk)); }
        }
#pragma unroll
        for (int c = 1; c < 64; ++c) { float a = x[c];
#pragma unroll
            for (int s4 = 0; s4 < (c + 3) / 4; ++s4) { const f32x4 av = *(const LAS f32x4*)(Am + c * 64 + 4 * s4);
#pragma unroll
                for (int e = 0; e < 4; ++e) if (4 * s4 + e < c) a -= av[e] * x[4 * s4 + e]; }
            x[c] = a; }
        if (pass < 2) { f32x4* dst = (f32x4*)(UT + ((size_t)cu * 128 + j) * 64);
#pragma unroll
            for (int q = 0; q < 16; ++q) dst[q] = (f32x4){x[4 * q], x[4 * q + 1], x[4 * q + 2], x[4 * q + 3]};
        } else { bf16* pw = WW + (size_t)t0 * 1024 + hd * 128 + perm32pos(j);
#pragma unroll
            for (int c = 0; c < 64; ++c) { *pw = (bf16)(pk2(x[c], 0.f) & 0xffffu); pw += 1024; asm volatile("" : "+v"(pw)); }
        }
    }
    }
    asm volatile("s_waitcnt vmcnt(0) lgkmcnt(0)" ::: "memory");
}

__device__ __forceinline__ void delta_scan(Frame& F, int hd, int half) {
    unsigned char* ws = F.ws; const int tid = F.tid, lane = F.lane, w = F.wave;
    const bf16* QDEC = (const bf16*)(ws + WS_QDEC); const bf16* KDT = (const bf16*)(ws + WS_KDT); const bf16* WW = (const bf16*)(ws + WS_WW);
    const float* UT = (const float*)(ws + WS_UT); const bf16* QKM = (const bf16*)(ws + WS_QKM); const float* GLAST = (const float*)(ws + WS_GLAST);
    float* OD = (float*)(ws + WS_ODELTA);
    constexpr int BUF = 57344;
    const int col = lane & 15, g = lane >> 4, col0 = half * 64 + 16 * (w & 3);
    f32x4 St[8];
#pragma unroll
    for (int i = 0; i < 8; ++i) St[i] = (f32x4){0.f, 0.f, 0.f, 0.f};
    u32x4 stg[7];
#define SCAN_LOAD(n) do { const int cu_ = (n) * 8 + hd; const size_t t0_ = (size_t)(n) * 64; \
        _Pragma("unroll") for (int k = 0; k < 7; ++k) { const int m_ = (tid + 512 * k) & 1023; \
            if (k < 2) stg[k] = *(const u32x4*)(WW + (t0_ + (m_ >> 4)) * 1024 + hd * 128 + (m_ & 15) * 8); \
            else if (k < 4) stg[k] = *(const u32x4*)(QDEC + (t0_ + (m_ >> 4)) * 1024 + hd * 128 + (m_ & 15) * 8); \
            else if (k < 6) stg[k] = *(const u32x4*)(KDT + ((size_t)cu_ * 128 + (m_ >> 3)) * 64 + (m_ & 7) * 8); \
            else stg[k] = *(const u32x4*)(QKM + (size_t)cu_ * 4096 + ((m_ & 511) >> 3) * 64 + (m_ & 7) * 8); } } while (0)
#define SCAN_STORE(b) do { LAS unsigned char* B_ = F.lds + (b) * BUF; \
        _Pragma("unroll") for (int k = 0; k < 7; ++k) { const int m_ = (tid + 512 * k) & 1023; \
            if (k < 2) *(LAS u32x4*)(B_ + offb(m_ >> 4, m_ & 15)) = stg[k]; \
            else if (k < 4) *(LAS u32x4*)(B_ + 16384 + offb(m_ >> 4, m_ & 15)) = stg[k]; \
            else if (k < 6) *(LAS u32x4*)(B_ + 32768 + off128(m_ >> 3, m_ & 7)) = stg[k]; \
            else *(LAS u32x4*)(B_ + 49152 + off128((m_ & 511) >> 3, m_ & 7)) = stg[k]; } } while (0)
    SCAN_LOAD(0); SCAN_STORE(0);
    __syncthreads();
    for (int n = 0; n < NCH; ++n) {
        const int cu = n * 8 + hd; const size_t t0 = (size_t)n * 64;
        if (n + 1 < NCH) SCAN_LOAD(n + 1);
        if (w < 4) {
            const LAS unsigned char* B = F.lds + (n & 1) * BUF;
            f32x4 ut[4];
#pragma unroll
            for (int rb = 0; rb < 4; ++rb) ut[rb] = *(const f32x4*)(UT + ((size_t)cu * 128 + col0 + col) * 64 + 16 * rb + 4 * g);
            const float dec = __expf(GLAST[cu]);
            bf16x8 sf[4];
#pragma unroll
            for (int ks = 0; ks < 4; ++ks) sf[ks] = pack8(St[2 * ks], St[2 * ks + 1]);
            f32x4 vn[4], o[4];
#pragma unroll
            for (int rb = 0; rb < 4; ++rb) { f32x4 a = (f32x4){0.f, 0.f, 0.f, 0.f}, q = (f32x4){0.f, 0.f, 0.f, 0.f};
#pragma unroll
                for (int ks = 0; ks < 4; ++ks) { const bf16x8 wf = *(const LAS bf16x8*)(B + offb(16 * rb + col, 4 * ks + g)); const bf16x8 qf = *(const LAS bf16x8*)(B + 16384 + offb(16 * rb + col, 4 * ks + g));
                    a = MFMA16(wf, sf[ks], a); q = MFMA16(qf, sf[ks], q); }
                vn[rb] = ut[rb] - a; o[rb] = q; }
            bf16x8 vf[2];
#pragma unroll
            for (int k2 = 0; k2 < 2; ++k2) vf[k2] = pack8(vn[2 * k2], vn[2 * k2 + 1]);
#pragma unroll
            for (int rb = 0; rb < 4; ++rb) {
#pragma unroll
                for (int k2 = 0; k2 < 2; ++k2) { const bf16x8 qk = *(const LAS bf16x8*)(B + 49152 + off128(16 * rb + col, 4 * k2 + g)); o[rb] = MFMA16(qk, vf[k2], o[rb]); }
#pragma unroll
                for (int i = 0; i < 4; ++i) OD[(t0 + 16 * rb + 4 * g + i) * 1024 + hd * 128 + col0 + col] = o[rb][i]; }
#pragma unroll
            for (int tt = 0; tt < 8; ++tt) { f32x4 s = St[tt] * dec;
#pragma unroll
                for (int k2 = 0; k2 < 2; ++k2) { const bf16x8 kd = *(const LAS bf16x8*)(B + 32768 + off128(16 * tt + col, 4 * k2 + g)); s = MFMA16(kd, vf[k2], s); }
                St[tt] = s; }
        }
        if (n + 1 < NCH) SCAN_STORE((n + 1) & 1);
        __syncthreads();
    }
#undef SCAN_LOAD
#undef SCAN_STORE
}
__device__ __forceinline__ void route_tokens(Frame& F) {
    unsigned char* ws = F.ws;
    const float* SSQ = (const float*)(ws + WS_SSQ2); const float* LG = (const float*)(ws + WS_LOGITS); float* RSTD2 = (float*)(ws + WS_RSTD2); float* WGT = (float*)(ws + WS_WGT);
    int* LIST = (int*)(ws + WS_LIST); unsigned* cnt = (unsigned*)(ws + WS_CTL) + CW_CNT;
    const float* bg = F.in[IN_BGROUP]; const float* be = F.in[IN_BEXPERT];
    for (int t = F.vcu * 512 + F.tid; t < S; t += F.G * 512) {
        float ss = 0.f;
#pragma unroll
        for (int i = 0; i < 8; ++i) { const f32x4 v = *(const f32x4*)(SSQ + (size_t)t * 32 + 4 * i); ss += (v[0] + v[1]) + (v[2] + v[3]); }
        const float rstd = __builtin_amdgcn_rsqf(ss * (1.f / D) + EPS);
        RSTD2[t] = rstd;
        const float* lg = LG + (size_t)t * 256;
        float gl[8]; float gmax = -__builtin_inff(); int gsel = 0;
#pragma unroll
        for (int i = 0; i < 8; ++i) { gl[i] = lg[i] * rstd + bg[i]; if (gl[i] > gmax) { gmax = gl[i]; gsel = i; } }
        float gsum = 0.f;
#pragma unroll
        for (int i = 0; i < 8; ++i) gsum += __expf(gl[i] - gmax);
        const float gate = 1.f / gsum;
        float v1 = -__builtin_inff(), v2 = -__builtin_inff(); int i1 = 0, i2 = 0;
#pragma unroll
        for (int i = 0; i < 8; ++i) { const float e = lg[8 + gsel * 8 + i] * rstd + be[gsel * 8 + i];
            if (e > v1) { v2 = v1; i2 = i1; v1 = e; i1 = i; } else if (e > v2) { v2 = e; i2 = i; } }
        const float w1 = 1.f / (1.f + __expf(v2 - v1)), w2 = 1.f - w1;
        const int e1 = gsel * 8 + i1, e2 = gsel * 8 + i2;
        const unsigned p1 = atomicAdd(cnt + e1 * 16, 1u); LIST[(size_t)e1 * 16384 + p1] = t * 2; WGT[t * 2] = gate * w1;
        const unsigned p2 = atomicAdd(cnt + e2 * 16, 1u); LIST[(size_t)e2 * 16384 + p2] = t * 2 + 1; WGT[t * 2 + 1] = gate * w2;
    }
}
__device__ __forceinline__ void build_ptab(Frame& F) {
    LAS int* pt = (LAS int*)(F.lds + PTAB_OFF);
    if (F.tid == 0) { unsigned* cnt = (unsigned*)(F.ws + WS_CTL) + CW_CNT; int np = 0;
        for (int e = 0; e < NEXP; ++e) { const int c = (int)__hip_atomic_load(cnt + e * 16, __ATOMIC_RELAXED, __HIP_MEMORY_SCOPE_AGENT);
            for (int off = 0; off < c; off += 256) { pt[np] = e; pt[192 + np] = off; pt[384 + np] = c; ++np; } }
        pt[576] = np; }
    __syncthreads();
}
__device__ __forceinline__ void final_rows(Frame& F) {
    const int gw = F.vcu * 8 + F.wave, NGW = F.G * 8; const bf16* Y = (const bf16*)(F.ws + WS_Y); const float* gf = F.in[IN_GFINAL];
    f32x4 gv[8];
#pragma unroll
    for (int j = 0; j < 8; ++j) gv[j] = *(const f32x4*)(gf + 4 * F.lane + 256 * j);
    for (int row = gw; row < S; row += NGW) {
        float* hr = F.out + (size_t)row * D; f32x4 v[8]; float ss = 0.f;
#pragma unroll
        for (int j = 0; j < 8; ++j) { v[j] = *(const f32x4*)(hr + 4 * F.lane + 256 * j);
            const u32x2 a = *(const u32x2*)(Y + (size_t)row * D + 4 * F.lane + 256 * j), b = *(const u32x2*)(Y + ((size_t)S + row) * D + 4 * F.lane + 256 * j);
            v[j][0] += __uint_as_float(a.x << 16) + __uint_as_float(b.x << 16); v[j][1] += __uint_as_float(a.x & 0xffff0000u) + __uint_as_float(b.x & 0xffff0000u);
            v[j][2] += __uint_as_float(a.y << 16) + __uint_as_float(b.y << 16); v[j][3] += __uint_as_float(a.y & 0xffff0000u) + __uint_as_float(b.y & 0xffff0000u);
            ss += (v[j][0] * v[j][0] + v[j][1] * v[j][1]) + (v[j][2] * v[j][2] + v[j][3] * v[j][3]); }
        const float rstd = __builtin_amdgcn_rsqf(wave_sum(ss) * (1.f / D) + EPS);
#pragma unroll
        for (int j = 0; j < 8; ++j) *(f32x4*)(hr + 4 * F.lane + 256 * j) = v[j] * rstd * gv[j];
    }
}

constexpr int NPH = 14;
struct Args { const float* in[24]; float* out; unsigned char* ws; int ph_lo, ph_hi; };
__global__ void __launch_bounds__(512, 2) mk_fwd(Args args) {
    extern __shared__ __attribute__((aligned(16))) unsigned char lds_raw[];
    Frame F;
    F.lds = (LAS unsigned char*)lds_raw;
    F.tid = threadIdx.x; F.lane = F.tid & 63; F.wave = __builtin_amdgcn_readfirstlane(F.tid >> 6);
    F.G = gridDim.x; { const int bx = blockIdx.x; F.vcu = (F.G % 8 == 0) ? (bx % 8) * (F.G / 8) + bx / 8 : bx; }
#pragma unroll
    for (int i = 0; i < 24; ++i) F.in[i] = args.in[i];
    F.out = args.out; F.ws = args.ws;
    unsigned char* ws = args.ws;
    volatile LAS unsigned* MISC = (volatile LAS unsigned*)(F.lds + MISC_OFF);
    if (F.tid < 64) MISC[F.tid] = 0u;
    __syncthreads();
    const int lo = args.ph_lo, hi = args.ph_hi;
    XcdBarrier bar; bar.bar = (unsigned*)(ws + WS_CTL) + CW_BAR; bar.x = 0; bar.st = nullptr;
    if (hi - lo > 1) bar = xcd_barrier_post((unsigned*)(ws + WS_CTL) + CW_BAR, MISC + 8);
#ifndef PH_MASK
#define PH_MASK 0xFFFFFFFFu
#endif
#define IN(k) (((PH_MASK >> (k)) & 1u) && lo <= (k) && (k) < hi)
#define SEAM(k) do { if (IN(k) && IN((k) + 1)) xcd_barrier(bar); } while (0)
    const int bx = blockIdx.x;
    if (IN(0)) { p0_prologue(F); SEAM(0); }
    if (IN(1)) {
        pg8::Gemm g{(const bf16*)(ws + WS_XN), (const bf16*)(ws + WS_WIN), D, 0, nullptr}; pg8::StaticOrder So; So.init(S, NPROJ, F.G, bx);
        EpiProj E{(bf16*)(ws + WS_QKVA), (bf16*)(ws + WS_QKVD), (bf16*)(ws + WS_Z)};
        pg8::gemm_phase<EpiProj, pg8::StaticOrder, true, true, false>(F.lds, g, So, E);
        SEAM(1);
    }
    if (IN(2)) { for (int cu = F.vcu * 8 + F.wave; cu < NCH * 8; cu += F.G * 8) delta_prep_unit(F, cu); SEAM(2); }
    if (IN(3)) {
        if (bx < 16) delta_scan(F, bx >> 1, bx & 1);
        else { const int naw = (F.G - 16) * 8; for (int wu = (bx - 16) * 8 + F.wave; wu < 3 * 8 * 512; wu += naw) dilated_unit(F, wu); }
        SEAM(3);
    }
    if (IN(4)) { for (int t = F.vcu * 8 + F.wave; t < S; t += F.G * 8) merge_token(F, t); SEAM(4); }
    if (IN(5)) {
        pg8::Gemm g{(const bf16*)(ws + WS_MIX), (const bf16*)(ws + WS_WOUT), D, 0, nullptr}; pg8::StaticOrder So; So.init(S, D, F.G, bx);
        EpiResid E{F.in[IN_X], F.out, (bf16*)(ws + WS_H1B), (float*)(ws + WS_SSQ1)};
        pg8::gemm_phase<EpiResid, pg8::StaticOrder, true, true, false>(F.lds, g, So, E);
        SEAM(5);
    }
    if (IN(6)) {
        { pg8::Gemm g{(const bf16*)(ws + WS_H1B), (const bf16*)(ws + WS_WQ), D, 0, nullptr}; pg8::StaticOrder So; So.init(S, 512, F.G, bx);
          EpiBf16 E{(bf16*)(ws + WS_QMEM), 512};
          pg8::gemm_phase<EpiBf16, pg8::StaticOrder, true, true, false>(F.lds, g, So, E); }
        { pg8::Gemm g{(const bf16*)(ws + WS_MEMN), (const bf16*)(ws + WS_WKV), D, 0, nullptr}; pg8::StaticOrder So; So.init(NMEM, 1024, F.G, (bx >= 128 && bx < 132) ? bx - 128 : -1);
          EpiBf16 E{(bf16*)(ws + WS_KVMEM), 1024};
          pg8::gemm_phase<EpiBf16, pg8::StaticOrder, true, true, false>(F.lds, g, So, E); }
        SEAM(6);
    }
    if (IN(7)) { for (int u = bx; u < 256; u += F.G) cross_unit(F, u); SEAM(7); }
    if (IN(8)) {
        pg8::Gemm g{(const bf16*)(ws + WS_OMEM), (const bf16*)(ws + WS_WO), 512, 0, nullptr}; pg8::StaticOrder So; So.init(S, D, F.G, bx);
        EpiResid E{F.out, F.out, (bf16*)(ws + WS_H2B), (float*)(ws + WS_SSQ2)};
        pg8::gemm_phase<EpiResid, pg8::StaticOrder, true, true, false>(F.lds, g, So, E);
        SEAM(8);
    }
    if (IN(9)) {
        pg8::Gemm g{(const bf16*)(ws + WS_H2B), (const bf16*)(ws + WS_WR), D, 0, nullptr}; pg8::StaticOrder So; So.init(S, 256, F.G, bx);
        EpiF32 E{(float*)(ws + WS_LOGITS), 256};
        pg8::gemm_phase<EpiF32, pg8::StaticOrder, true, true, false>(F.lds, g, So, E);
        SEAM(9);
    }
    if (IN(10)) { route_tokens(F); SEAM(10); }
    if (IN(11)) {
        build_ptab(F);
        pg8::Gemm g{(const bf16*)(ws + WS_H2B), (const bf16*)(ws + WS_WGU), D, (size_t)1024 * D, (const int*)(ws + WS_LIST)};
        pg8::MoeOrder<2> So{(const LAS int*)(F.lds + PTAB_OFF), F.G, F.vcu};
        EpiHid E{(bf16*)(ws + WS_HID), (const int*)(ws + WS_LIST), (const float*)(ws + WS_RSTD2)};
        pg8::gemm_phase<EpiHid, pg8::MoeOrder<2>, true, true, true>(F.lds, g, So, E);
        SEAM(11);
    }
    if (IN(12)) {
        build_ptab(F);
        pg8::Gemm g{(const bf16*)(ws + WS_HID), (const bf16*)(ws + WS_WD), DE, (size_t)D * DE, nullptr};
        pg8::MoeOrder<3> So{(const LAS int*)(F.lds + PTAB_OFF), F.G, F.vcu};
        EpiDown E{(bf16*)(ws + WS_Y), (const int*)(ws + WS_LIST), (const float*)(ws + WS_WGT)};
        pg8::gemm_phase<EpiDown, pg8::MoeOrder<3>, true, true, false>(F.lds, g, So, E);
        SEAM(12);
    }
    if (IN(13)) final_rows(F);
#undef IN
#undef SEAM
}

extern "C" void kernel_launch(void* const* d_in, const int* in_sizes, int n_in, void* d_out, int out_size, void* d_ws, size_t ws_size, hipStream_t stream) {
    static int grid = 0;
    if (grid == 0) {
        if (n_in != 24 || out_size != S * D || ws_size < WS_END) { fprintf(stderr, "kernel_launch: unexpected shapes (n_in %d out %d ws %zu)\n", n_in, out_size, ws_size); grid = -1; return; }
        int dev = 0, cus = 0;
        if (hipGetDevice(&dev) != hipSuccess || hipDeviceGetAttribute(&cus, hipDeviceAttributeMultiprocessorCount, dev) != hipSuccess) { grid = -1; return; }
        if (hipFuncSetAttribute((const void*)mk_fwd, hipFuncAttributeMaxDynamicSharedMemorySize, LDS_BYTES) != hipSuccess) { fprintf(stderr, "kernel_launch: hipFuncSetAttribute failed\n"); grid = -1; return; }
        int per_cu = 0; (void)hipOccupancyMaxActiveBlocksPerMultiprocessor(&per_cu, (const void*)mk_fwd, 512, LDS_BYTES); (void)hipGetLastError();
        grid = cus;
        if (grid % 8 != 0 || grid < 64) { fprintf(stderr, "kernel_launch: unexpected CU count %d\n", cus); }
    }
    if (grid < 0) return;
    (void)hipMemsetAsync((char*)d_ws + WS_CTL, 0, CTL_ZERO_BYTES, stream);
    Args a{};
    for (int i = 0; i < 24; ++i) a.in[i] = (const float*)d_in[i];
    a.out = (float*)d_out; a.ws = (unsigned char*)d_ws;
#if MK_N_LAUNCHES == 1
    a.ph_lo = 0; a.ph_hi = NPH;
    hipLaunchKernelGGL(mk_fwd, dim3(grid), dim3(512), LDS_BYTES, stream, a);
#else
    for (int p = 0; p < NPH; ++p) { a.ph_lo = p; a.ph_hi = p + 1; hipLaunchKernelGGL(mk_fwd, dim3(grid), dim3(512), LDS_BYTES, stream, a); }
#endif
}
```

```cpp
#include <hip/hip_runtime.h>
#include <cstdio>
#include <cstdint>
#include <utility>

#define LAS __attribute__((address_space(3)))
#define GAS __attribute__((address_space(1)))
typedef unsigned short bf16;
typedef short bf16x8 __attribute__((ext_vector_type(8)));
typedef short s16x4 __attribute__((ext_vector_type(4)));
typedef float f32x2 __attribute__((ext_vector_type(2)));
typedef float f32x4 __attribute__((ext_vector_type(4)));
typedef float f32x16 __attribute__((ext_vector_type(16)));
typedef unsigned u32x2 __attribute__((ext_vector_type(2)));
typedef unsigned u32x4 __attribute__((ext_vector_type(4)));
typedef __bf16 bf16x2_t __attribute__((ext_vector_type(2)));
typedef GAS unsigned gu32;

#ifndef TS_A
#define TS_A -1
#define TS_B -1
#endif
#ifndef MK_N_LAUNCHES
#define MK_N_LAUNCHES 1
#endif

constexpr int S = 16384, D = 2048, NMEM = 256, HD = 128;
constexpr int NCH = S / 64;
constexpr int NPROJ = 7168, LDWIN = 7184;
constexpr int NEXP = 64, DE = 512;
constexpr float EPS = 1e-6f;
constexpr float LOG2E = 1.4426950408889634f, LN2 = 0.6931471805599453f;

constexpr size_t MiB = 1u << 20;
constexpr size_t WS_CTL = 0, CTL_ZERO_BYTES = 64 * 1024;
constexpr size_t WS_WIN = 1 * MiB, WS_WOUT = 29 * MiB, WS_WQ = 37 * MiB, WS_WKV = 39 * MiB, WS_WO = 43 * MiB, WS_WR = 45 * MiB, WS_WGU = 46 * MiB, WS_WD = 302 * MiB;
constexpr size_t WS_QKVA = 430 * MiB, WS_QKVD = 526 * MiB, WS_Z = 622 * MiB;
constexpr size_t WS_MIX = 430 * MiB;
constexpr size_t WS_HID = 430 * MiB, WS_Y = 478 * MiB;
constexpr size_t WS_ATTO = 654 * MiB, WS_LSE = 750 * MiB;
constexpr size_t WS_H2B = 654 * MiB;
constexpr size_t WS_XN = 752 * MiB;
constexpr size_t WS_QDEC = 752 * MiB, WS_KDT = 784 * MiB, WS_WW = 816 * MiB, WS_UT = 848 * MiB, WS_QKM = 912 * MiB, WS_QN = 928 * MiB, WS_KN = 960 * MiB;
constexpr size_t WS_SFRAG = 526 * MiB, WS_VFRAG = 590 * MiB;
constexpr size_t WS_ODELTA = 928 * MiB;
constexpr size_t WS_H1B = 752 * MiB, WS_QMEM = 816 * MiB, WS_OMEM = 832 * MiB, WS_LOGITS = 848 * MiB;
constexpr size_t WS_BA = 992 * MiB, WS_MEMN = 994 * MiB, WS_KVMEM = 995 * MiB, WS_SSQ1 = 996 * MiB, WS_SSQ2 = 998 * MiB, WS_RSTD2 = 1000 * MiB;
constexpr size_t WS_WGT = 1000 * MiB + 512 * 1024, WS_LIST = 1001 * MiB, WS_GLAST = 1005 * MiB, WS_END = 1006 * MiB;
constexpr int CW_TMO = 0, CW_CNT = 1024  , CW_PROG = 2560  , CW_CONVQ = 3200  , CW_BAR = 4096;

constexpr int RING_BYTES = 131072;
constexpr int MISC_OFF = RING_BYTES;
constexpr int PTAB_OFF = MISC_OFF + 1024;
constexpr int LDS_BYTES = 147456;
constexpr int WAVE_LDS = 16384;
constexpr int PREP_SMALL_OFF = MISC_OFF + 4096;

__device__ __forceinline__ unsigned pk2(float lo, float hi) { f32x2 v = {lo, hi}; return __builtin_bit_cast(unsigned, __builtin_convertvector(v, bf16x2_t)); }
__device__ __forceinline__ float bf2f(unsigned short b) { return __uint_as_float((unsigned)b << 16); }
__device__ __forceinline__ bf16x8 pack8(f32x4 a, f32x4 b) { u32x4 w = {pk2(a[0], a[1]), pk2(a[2], a[3]), pk2(b[0], b[1]), pk2(b[2], b[3])}; return __builtin_bit_cast(bf16x8, w); }
__device__ __forceinline__ float wave_sum_dpp(float v) {
    v += __int_as_float(__builtin_amdgcn_update_dpp(0, __float_as_int(v), 0xB1, 0xf, 0xf, true));
    v += __int_as_float(__builtin_amdgcn_update_dpp(0, __float_as_int(v), 0x4E, 0xf, 0xf, true));
    v += __int_as_float(__builtin_amdgcn_update_dpp(0, __float_as_int(v), 0x124, 0xf, 0xf, true));
    v += __int_as_float(__builtin_amdgcn_update_dpp(0, __float_as_int(v), 0x128, 0xf, 0xf, true));
    const int iv = __float_as_int(v);
    return (__int_as_float(__builtin_amdgcn_readlane(iv, 0)) + __int_as_float(__builtin_amdgcn_readlane(iv, 16))) + (__int_as_float(__builtin_amdgcn_readlane(iv, 32)) + __int_as_float(__builtin_amdgcn_readlane(iv, 48)));
}
__device__ __forceinline__ float wave_sum(float v) {
#pragma unroll
    for (int o = 1; o < 64; o <<= 1) v += __shfl_xor(v, o);
    return v;
}

namespace pg8 {
#define PG8_LAS __attribute__((address_space(3)))
typedef unsigned short bf16_t;
constexpr int BM = 256, BK = 64, HALF = 128, HTB = HALF * BK * 2, STAGE_BYTES = 8 * HTB, NXCD = 8, WGM = 8;
__host__ __device__ __forceinline__ int lds_byte(int r, int c) { const int st = (r >> 4) * 2 + (c >> 5), rr = r & 15, cc = c & 31, ob = rr * 64 + cc * 2; return st * 1024 + (ob ^ (((ob >> 9) & 1) << 5)); }
__host__ __device__ __forceinline__ void stage_rc(int b, int& R, int& C) { const int st = b / 1024, sb = b % 1024, swz = sb ^ (((sb >> 9) & 1) << 5); R = (st >> 1) * 16 + swz / 64; C = (st & 1) * 32 + (swz % 64) / 2; }
__host__ __device__ __forceinline__ int perm32(int rho) { const int n = rho >> 4, i = rho & 15; return 8 * (i >> 2) + 4 * n + (i & 3); }

struct Unit { int pm, pn, e, roff, cnt; };
struct Gemm { const bf16_t* A; const bf16_t* Bt; int K; size_t bstride; const int* list; };

struct StaticOrder {
    int nM, nN, nwg, G, c;
    __host__ __device__ void init(int M, int N, int G_, int c_) { nM = M / BM; nN = N / BM; nwg = nM * nN; G = G_; c = c_; }
    __host__ __device__ __forceinline__ bool next(int i, Unit& u) const {
        if (c < 0) return false;
        const long L = (long)i * G + c; if (L >= nwg) return false;
        int wgid = (int)L; { const int q = nwg / NXCD, r = nwg % NXCD, xcd = wgid % NXCD, off = wgid / NXCD; wgid = (xcd < r ? xcd * (q + 1) : r * (q + 1) + (xcd - r) * q) + off; }
        const int nig = WGM * nN, gid = wgid / nig, fm = gid * WGM, gsz = (nM - fm) < WGM ? (nM - fm) : WGM;
        u.pm = fm + ((wgid % nig) % gsz); u.pn = (wgid % nig) / gsz; u.e = 0; u.roff = 0; u.cnt = 0; return true;
    }
};
template <int LNT> struct MoeOrder {
    const PG8_LAS int* ptab; int G, vcu;
    __device__ __forceinline__ bool next(int i, Unit& u) const {
        const int np = ptab[576], NU = np << LNT, full = NU / G;
        int U = i * G + vcu;
        if (i >= full) {
            if (i > full) return false;
            const int rem = NU - full * G, r8 = (((rem + 7) >> 3) + (1 << LNT) - 1) & ~((1 << LNT) - 1), xg = vcu / (G >> 3), j = vcu % (G >> 3);
            if (j >= r8) return false;
            U = full * G + xg * r8 + j;
        }
        const int p = U >> LNT;
        if (p >= np) return false;
        u.pm = p; u.pn = U & ((1 << LNT) - 1); u.e = ptab[p]; u.roff = ptab[192 + p]; u.cnt = ptab[384 + p]; return true;
    }
};

template <class Epi, class Sched, bool ALIGN_EPI, bool SP2, bool GATHER>
__device__ __forceinline__ void gemm_phase(PG8_LAS unsigned char* lds, const Gemm g, const Sched& S, const Epi& E) {
    const int tid = threadIdx.x, wid = __builtin_amdgcn_readfirstlane(tid >> 6), lane = tid & 63, wr = wid >> 2, wc = wid & 3, fr = lane & 15, fq = lane >> 4;
    const int K = g.K, nt = K / BK;
    unsigned voffA[2], voffB[2]; int RA[2], CA2[2];
#pragma unroll
    for (int i = 0; i < 2; ++i) { int R, C; stage_rc(tid * 16 + i * 8192, R, C); const int Rb = Epi::PERM ? ((R & ~31) + perm32(R & 31)) : R;
        voffA[i] = (unsigned)(R * K + C) * 2u; voffB[i] = (unsigned)(Rb * K + C) * 2u; RA[i] = R; CA2[i] = C * 2; }
    const size_t kstep = (size_t)(BK * 2);
    const size_t hstep = (size_t)HALF * K * 2;
    const size_t tstep = 2 * hstep;
    const unsigned ldsw = (unsigned)wid * 1024u;
    const int aoff = lds_byte(wr * 64 + fr, fq * 8), boff = lds_byte(wc * 32 + fr, fq * 8);
#define PG8_SA(b, h) (((b) * 2 + (h)) * HTB)
#define PG8_SB(b, h) ((4 + (b) * 2 + (h)) * HTB)
#define PG8_STAGE(bufoff, gbase, voff) do { _Pragma("unroll") for (int _i = 0; _i < 2; ++_i) \
        __builtin_amdgcn_global_load_lds((const unsigned*)((const char*)(gbase) + (voff)[_i]), (PG8_LAS unsigned*)(lds + (bufoff) + ldsw + _i * 8192), 16, 0, 0); } while (0)
#define PG8_STAGEA(bufoff, gbase, h, V) do { if constexpr (GATHER) { _Pragma("unroll") for (int _i = 0; _i < 2; ++_i) \
        __builtin_amdgcn_global_load_lds((const unsigned*)((const char*)(gbase) + V[h][_i]), (PG8_LAS unsigned*)(lds + (bufoff) + ldsw + _i * 8192), 16, 0, 0); } \
        else { PG8_STAGE(bufoff, (const char*)(gbase) + (h) * hstep, voffA); } } while (0)
#define PG8_LDA(dst, b, h) do { _Pragma("unroll") for (int m = 0; m < 4; ++m) _Pragma("unroll") for (int k = 0; k < 2; ++k) dst[m][k] = *(const PG8_LAS bf16x8*)(lds + PG8_SA(b, h) + aoff + m * 2048 + k * 1024); } while (0)
#define PG8_LDB(dst, b, h) do { _Pragma("unroll") for (int n = 0; n < 2; ++n) _Pragma("unroll") for (int k = 0; k < 2; ++k) dst[n][k] = *(const PG8_LAS bf16x8*)(lds + PG8_SB(b, h) + boff + n * 2048 + k * 1024); } while (0)
#define PG8_MMA(ai, bj, At, Bt) do { __builtin_amdgcn_s_setprio(1); _Pragma("unroll") for (int m = 0; m < 4; ++m) _Pragma("unroll") for (int n = 0; n < 2; ++n) _Pragma("unroll") for (int k = 0; k < 2; ++k) \
        acc[ai][bj][m][n] = __builtin_amdgcn_mfma_f32_16x16x32_bf16(Bt[n][k], At[m][k], acc[ai][bj][m][n], 0, 0, 0); __builtin_amdgcn_s_setprio(0); } while (0)
#define PG8_WAIT_V(n) asm volatile("s_waitcnt vmcnt(" #n ")" ::: "memory")
#define PG8_WAIT_L(n) asm volatile("s_waitcnt lgkmcnt(" #n ")" ::: "memory")
#define PG8_BAR __builtin_amdgcn_s_barrier()
#define PG8_SCHED __builtin_amdgcn_sched_barrier(0)
#define PG8_GOFF(V, u) do { if constexpr (GATHER) { _Pragma("unroll") for (int _h = 0; _h < 2; ++_h) _Pragma("unroll") for (int _i = 0; _i < 2; ++_i) { \
        int _idx = (u).roff + 128 * _h + RA[_i]; _idx = _idx < (u).cnt ? _idx : 0; const int _id = g.list[(size_t)(u).e * 16384 + _idx]; \
        V[_h][_i] = (unsigned)(_id >> 1) * (unsigned)(K * 2) + (unsigned)CA2[_i]; } } } while (0)
    Unit cur, nxt; int ui = 0;
    if (!S.next(0, cur)) return;
    f32x4 acc[2][2][4][2];
#pragma unroll
    for (int a = 0; a < 2; ++a)
#pragma unroll
        for (int b = 0; b < 2; ++b)
#pragma unroll
            for (int m = 0; m < 4; ++m)
#pragma unroll
                for (int n = 0; n < 2; ++n) acc[a][b][m][n] = (f32x4){0.f, 0.f, 0.f, 0.f};
    bf16x8 At[4][2], B0[2][2], B1[2][2];
    unsigned cV[2][2] = {{0u, 0u}, {0u, 0u}}, nV[2][2] = {{0u, 0u}, {0u, 0u}}, sV[2][2] = {{0u, 0u}, {0u, 0u}};
    PG8_GOFF(cV, cur);
    const char* cA = GATHER ? (const char*)g.A : (const char*)g.A + (size_t)cur.pm * tstep;
    const char* cB = (const char*)g.Bt + ((size_t)cur.e * g.bstride) * 2 + (size_t)cur.pn * tstep;
    if constexpr (SP2) {
        PG8_STAGE(PG8_SB(0, 0), cB, voffB); PG8_STAGE(PG8_SB(0, 1), cB + hstep, voffB); PG8_STAGEA(PG8_SA(0, 0), cA, 0, cV); PG8_STAGEA(PG8_SA(0, 1), cA, 1, cV);
        if (wr == 1) PG8_BAR;
        PG8_WAIT_V(2); PG8_BAR;
        PG8_STAGE(PG8_SB(1, 0), cB + kstep, voffB); PG8_STAGEA(PG8_SA(1, 0), cA + kstep, 0, cV); PG8_STAGE(PG8_SB(1, 1), cB + hstep + kstep, voffB);
        PG8_WAIT_V(6); PG8_BAR;
    } else {
        PG8_STAGE(PG8_SB(0, 0), cB, voffB); PG8_STAGEA(PG8_SA(0, 0), cA, 0, cV); PG8_STAGE(PG8_SB(0, 1), cB + hstep, voffB); PG8_STAGEA(PG8_SA(0, 1), cA, 1, cV);
        if (wr == 1) PG8_BAR;
        PG8_WAIT_V(4); PG8_BAR;
        PG8_STAGE(PG8_SB(1, 0), cB + kstep, voffB); PG8_STAGEA(PG8_SA(1, 0), cA + kstep, 0, cV); PG8_STAGE(PG8_SB(1, 1), cB + hstep + kstep, voffB);
        PG8_WAIT_V(6); PG8_BAR;
    }
    for (;;) {
        const bool has_next = S.next(ui + 1, nxt);
        if (has_next) { PG8_GOFF(nV, nxt); }
        const char* nA = has_next ? (GATHER ? (const char*)g.A : (const char*)g.A + (size_t)nxt.pm * tstep) : cA;
        const char* nB = has_next ? (const char*)g.Bt + ((size_t)nxt.e * g.bstride) * 2 + (size_t)nxt.pn * tstep : cB;
        if constexpr (GATHER) { if (!has_next) {
#pragma unroll
            for (int h = 0; h < 2; ++h)
#pragma unroll
                for (int i = 0; i < 2; ++i) nV[h][i] = cV[h][i]; } }
        for (int t = 0; t < nt; t += 2) {
            const bool last = (t == nt - 2);
            const char* a1 = cA + (size_t)(t + 1) * kstep;
            const char* a2 = last ? nA : cA + (size_t)(t + 2) * kstep; const char* b2 = last ? nB : cB + (size_t)(t + 2) * kstep;
            const char* a3 = a2 + kstep; const char* b3 = b2 + kstep;
            if constexpr (GATHER) {
#pragma unroll
                for (int h = 0; h < 2; ++h)
#pragma unroll
                    for (int i = 0; i < 2; ++i) sV[h][i] = last ? nV[h][i] : cV[h][i]; }
            if constexpr (SP2) {
            PG8_LDB(B0, 0, 0); PG8_LDB(B1, 0, 1); PG8_SCHED; PG8_LDA(At, 0, 0); PG8_STAGEA(PG8_SA(1, 1), a1, 1, cV);
            PG8_WAIT_V(8); PG8_WAIT_L(0); PG8_BAR; PG8_MMA(0, 0, At, B0); PG8_MMA(0, 1, At, B1); PG8_BAR; PG8_SCHED;
            PG8_LDA(At, 0, 1); PG8_STAGE(PG8_SB(0, 0), b2, voffB); PG8_STAGE(PG8_SB(0, 1), b2 + hstep, voffB); PG8_STAGEA(PG8_SA(0, 0), a2, 0, sV);
            PG8_WAIT_V(8); PG8_WAIT_L(0); PG8_BAR; PG8_MMA(1, 0, At, B0); PG8_MMA(1, 1, At, B1); PG8_BAR; PG8_SCHED;
            PG8_LDB(B0, 1, 0); PG8_LDB(B1, 1, 1); PG8_SCHED; PG8_LDA(At, 1, 0); PG8_STAGEA(PG8_SA(0, 1), a2, 1, sV);
            PG8_WAIT_V(8); PG8_WAIT_L(0); PG8_BAR; PG8_MMA(0, 0, At, B0); PG8_MMA(0, 1, At, B1); PG8_BAR; PG8_SCHED;
            PG8_LDA(At, 1, 1); PG8_STAGE(PG8_SB(1, 0), b3, voffB); PG8_STAGE(PG8_SB(1, 1), b3 + hstep, voffB); PG8_STAGEA(PG8_SA(1, 0), a3, 0, sV);
            PG8_WAIT_V(8); PG8_WAIT_L(0); PG8_BAR; PG8_MMA(1, 0, At, B0); PG8_MMA(1, 1, At, B1); PG8_BAR; PG8_SCHED;
            } else {
            PG8_LDB(B0, 0, 0); PG8_SCHED; PG8_LDA(At, 0, 0); PG8_STAGEA(PG8_SA(1, 1), a1, 1, cV);
            PG8_WAIT_L(8); PG8_BAR; PG8_WAIT_L(0); PG8_MMA(0, 0, At, B0); PG8_BAR; PG8_SCHED;
            PG8_LDB(B1, 0, 1); PG8_STAGE(PG8_SB(0, 0), b2, voffB);
            PG8_BAR; PG8_WAIT_L(0); PG8_MMA(0, 1, At, B1); PG8_BAR;
            PG8_LDA(At, 0, 1); PG8_STAGEA(PG8_SA(0, 0), a2, 0, sV);
            PG8_BAR; PG8_WAIT_L(0); PG8_MMA(1, 0, At, B0); PG8_BAR; PG8_SCHED;
            PG8_STAGE(PG8_SB(0, 1), b2 + hstep, voffB);
            PG8_WAIT_V(6); PG8_BAR; PG8_MMA(1, 1, At, B1); PG8_BAR;
            PG8_LDB(B0, 1, 0); PG8_SCHED; PG8_LDA(At, 1, 0); PG8_STAGEA(PG8_SA(0, 1), a2, 1, sV);
            PG8_WAIT_L(8); PG8_BAR; PG8_WAIT_L(0); PG8_MMA(0, 0, At, B0); PG8_BAR; PG8_SCHED;
            PG8_LDB(B1, 1, 1); PG8_STAGE(PG8_SB(1, 0), b3, voffB);
            PG8_BAR; PG8_WAIT_L(0); PG8_MMA(0, 1, At, B1); PG8_BAR;
            PG8_LDA(At, 1, 1); PG8_STAGEA(PG8_SA(1, 0), a3, 0, sV);
            PG8_BAR; PG8_WAIT_L(0); PG8_MMA(1, 0, At, B0); PG8_BAR; PG8_SCHED;
            PG8_STAGE(PG8_SB(1, 1), b3 + hstep, voffB);
            PG8_WAIT_V(6); PG8_BAR; PG8_MMA(1, 1, At, B1); PG8_BAR;
            }
        }
        if constexpr (ALIGN_EPI) { if (wr == 0) PG8_BAR; }
        E(acc, cur, wr, wc, fr, fq);
        if (!has_next) break;
#pragma unroll
        for (int a = 0; a < 2; ++a)
#pragma unroll
            for (int b = 0; b < 2; ++b)
#pragma unroll
                for (int m = 0; m < 4; ++m)
#pragma unroll
                    for (int n = 0; n < 2; ++n) acc[a][b][m][n] = (f32x4){0.f, 0.f, 0.f, 0.f};
        cur = nxt; cA = nA; cB = nB; ++ui;
        if constexpr (GATHER) {
#pragma unroll
            for (int h = 0; h < 2; ++h)
#pragma unroll
                for (int i = 0; i < 2; ++i) cV[h][i] = nV[h][i]; }
        if constexpr (ALIGN_EPI) { if (wr == 1) PG8_BAR; }
    }
    PG8_WAIT_V(0);
    if constexpr (!ALIGN_EPI) { if (wr == 0) PG8_BAR; }
    PG8_BAR;
#undef PG8_SA
#undef PG8_SB
#undef PG8_STAGE
#undef PG8_STAGEA
#undef PG8_LDA
#undef PG8_LDB
#undef PG8_MMA
#undef PG8_WAIT_V
#undef PG8_WAIT_L
#undef PG8_BAR
#undef PG8_SCHED
#undef PG8_GOFF
}
}
struct EpiProj {
    static constexpr bool PERM = true;
    bf16 *qkva, *qkvd, *z;
    __device__ __forceinline__ void operator()(const f32x4 (&acc)[2][2][4][2], const pg8::Unit& u, int wr, int wc, int fr, int fq) const {
        bf16* base; int ldc, colt; const int pn = u.pn;
        if (pn < 12) { base = qkva; ldc = 3072; colt = pn * 256; } else if (pn < 24) { base = qkvd; ldc = 3072; colt = (pn - 12) * 256; } else { base = z; ldc = 1024; colt = (pn - 24) * 256; }
        const int row0 = u.pm * 256 + wr * 64 + fr, col0 = colt + wc * 32 + 8 * fq;
#pragma unroll
        for (int ai = 0; ai < 2; ++ai)
#pragma unroll
            for (int m = 0; m < 4; ++m) { bf16* rowp = base + (size_t)(row0 + ai * 128 + m * 16) * ldc + col0;
#pragma unroll
                for (int bj = 0; bj < 2; ++bj) { const f32x4 v0 = acc[ai][bj][m][0], v1 = acc[ai][bj][m][1];
                    u32x4 w; w.x = pk2(v0[0], v0[1]); w.y = pk2(v0[2], v0[3]); w.z = pk2(v1[0], v1[1]); w.w = pk2(v1[2], v1[3]);
                    *(u32x4*)(rowp + bj * 128) = w; } }
    }
};
struct EpiBf16 {
    static constexpr bool PERM = true;
    bf16* O; int ldc;
    __device__ __forceinline__ void operator()(const f32x4 (&acc)[2][2][4][2], const pg8::Unit& u, int wr, int wc, int fr, int fq) const {
        const int row0 = u.pm * 256 + wr * 64 + fr, col0 = u.pn * 256 + wc * 32 + 8 * fq;
#pragma unroll
        for (int ai = 0; ai < 2; ++ai)
#pragma unroll
            for (int m = 0; m < 4; ++m) { bf16* rowp = O + (size_t)(row0 + ai * 128 + m * 16) * ldc + col0;
#pragma unroll
                for (int bj = 0; bj < 2; ++bj) { const f32x4 v0 = acc[ai][bj][m][0], v1 = acc[ai][bj][m][1];
                    u32x4 w; w.x = pk2(v0[0], v0[1]); w.y = pk2(v0[2], v0[3]); w.z = pk2(v1[0], v1[1]); w.w = pk2(v1[2], v1[3]);
                    *(u32x4*)(rowp + bj * 128) = w; } }
    }
};
struct EpiF32 {
    static constexpr bool PERM = false;
    float* C; int ldc;
    __device__ __forceinline__ void operator()(const f32x4 (&acc)[2][2][4][2], const pg8::Unit& u, int wr, int wc, int fr, int fq) const {
        const int row0 = u.pm * 256 + wr * 64 + fr, col0 = u.pn * 256 + wc * 32 + 4 * fq;
#pragma unroll
        for (int ai = 0; ai < 2; ++ai)
#pragma unroll
            for (int m = 0; m < 4; ++m) { float* rowp = C + (size_t)(row0 + ai * 128 + m * 16) * ldc + col0;
#pragma unroll
                for (int bj = 0; bj < 2; ++bj)
#pragma unroll
                    for (int n = 0; n < 2; ++n) *(f32x4*)(rowp + bj * 128 + n * 16) = acc[ai][bj][m][n]; }
    }
};
template <bool BASE_BF16>
struct EpiResid {
    static constexpr bool PERM = false;
    const void* base; bf16* hb; float* ssq;
    __device__ __forceinline__ void operator()(const f32x4 (&acc)[2][2][4][2], const pg8::Unit& u, int wr, int wc, int fr, int fq) const {
        const int row0 = u.pm * 256 + wr * 64 + fr, col0 = u.pn * 256 + wc * 32 + 4 * fq;
#pragma unroll
        for (int ai = 0; ai < 2; ++ai)
#pragma unroll
            for (int m = 0; m < 4; ++m) { const int row = row0 + ai * 128 + m * 16; const size_t off = (size_t)row * 2048 + col0; float ss = 0.f;
#pragma unroll
                for (int bj = 0; bj < 2; ++bj)
#pragma unroll
                    for (int n = 0; n < 2; ++n) { f32x4 b;
                        if (BASE_BF16) { const u32x2 t = *(const u32x2*)((const bf16*)base + off + bj * 128 + n * 16); b = (f32x4){__uint_as_float(t.x << 16), __uint_as_float(t.x & 0xffff0000u), __uint_as_float(t.y << 16), __uint_as_float(t.y & 0xffff0000u)}; }
                        else b = *(const f32x4*)((const float*)base + off + bj * 128 + n * 16);
                        const f32x4 o = b + acc[ai][bj][m][n];
                        ss += (o[0] * o[0] + o[1] * o[1]) + (o[2] * o[2] + o[3] * o[3]);
                        u32x2 w; w.x = pk2(o[0], o[1]); w.y = pk2(o[2], o[3]); *(u32x2*)(hb + off + bj * 128 + n * 16) = w; }
                ss += __shfl_xor(ss, 16); ss += __shfl_xor(ss, 32);
                if (fq == 0) ssq[(size_t)row * 32 + u.pn * 4 + wc] = ss; }
    }
};
struct EpiHid {
    static constexpr bool PERM = false;
    bf16* hid; const int* list; const float* rstd2;
    __device__ __forceinline__ void operator()(const f32x4 (&acc)[2][2][4][2], const pg8::Unit& u, int wr, int wc, int fr, int fq) const {
#pragma unroll
        for (int ai = 0; ai < 2; ++ai)
#pragma unroll
            for (int m = 0; m < 4; ++m) { const int r = ai * 128 + wr * 64 + m * 16 + fr, idx = u.roff + r;
                if (idx < u.cnt) { const int id = list[(size_t)u.e * 16384 + idx]; const float rs = rstd2[id >> 1];
                    bf16* rowp = hid + (size_t)(u.pm * 256 + r) * 512 + u.pn * 128 + wc * 16 + fq * 4;
#pragma unroll
                    for (int bj = 0; bj < 2; ++bj) { const f32x4 gt = acc[ai][bj][m][0] * rs, up = acc[ai][bj][m][1] * rs; f32x4 h;
#pragma unroll
                        for (int e = 0; e < 4; ++e) h[e] = gt[e] * __builtin_amdgcn_rcpf(1.f + __expf(-gt[e])) * up[e];
                        u32x2 w; w.x = pk2(h[0], h[1]); w.y = pk2(h[2], h[3]); *(u32x2*)(rowp + bj * 64) = w; } } }
    }
};
struct EpiDown {
    static constexpr bool PERM = true;
    bf16* Y; const int* list; const float* wgt;
    __device__ __forceinline__ void operator()(const f32x4 (&acc)[2][2][4][2], const pg8::Unit& u, int wr, int wc, int fr, int fq) const {
#pragma unroll
        for (int ai = 0; ai < 2; ++ai)
#pragma unroll
            for (int m = 0; m < 4; ++m) { const int r = ai * 128 + wr * 64 + m * 16 + fr, idx = u.roff + r;
                if (idx < u.cnt) { const int id = list[(size_t)u.e * 16384 + idx]; const float w8 = wgt[id];
                    bf16* rowp = Y + ((size_t)(id & 1) * S + (id >> 1)) * 2048 + u.pn * 256 + wc * 32 + 8 * fq;
#pragma unroll
                    for (int bj = 0; bj < 2; ++bj) { const f32x4 v0 = acc[ai][bj][m][0] * w8, v1 = acc[ai][bj][m][1] * w8;
                        u32x4 w; w.x = pk2(v0[0], v0[1]); w.y = pk2(v0[2], v0[3]); w.z = pk2(v1[0], v1[1]); w.w = pk2(v1[2], v1[3]);
                        *(u32x4*)(rowp + bj * 128) = w; } } }
    }
};

#define XB_TMO      128
#define XB_XCNT(j)  (256  + 64 * (j))
#define XB_XSUB(j)  (1280 + 64 * (j))
#define XB_XGEN(j)  (2304 + 64 * (j))
#define XB_TOP      3328
#define XB_TOPGEN   3392
#define XCD_BAR_WORDS 3456
#define XB_SPIN_CAP (1u << 18)
__device__ __forceinline__ unsigned xb_ld(unsigned* p)              { return __hip_atomic_load(p, __ATOMIC_RELAXED, __HIP_MEMORY_SCOPE_AGENT); }
__device__ __forceinline__ unsigned xb_add(unsigned* p, unsigned v) { return __hip_atomic_fetch_add(p, v, __ATOMIC_RELAXED, __HIP_MEMORY_SCOPE_AGENT); }
__device__ __forceinline__ unsigned xb_xcc_id() { return (unsigned)__builtin_amdgcn_s_getreg((3 << 11) | 20) & 0xFu; }
#define XB_SPIN(cond, bar) do { unsigned _sp = 0; while (cond) { __builtin_amdgcn_s_sleep(1); \
    if ((++_sp & 255u) == 0u) { if (xb_ld(&(bar)[XB_TMO])) break; if (_sp > XB_SPIN_CAP) { atomicAdd(&(bar)[XB_TMO], 1u); break; } } } } while (0)
struct XcdBarrier { unsigned* bar; unsigned x; volatile LAS unsigned* st; };
__device__ __forceinline__ XcdBarrier xcd_barrier_post(unsigned* bar, volatile LAS unsigned* st) {
    XcdBarrier b; b.bar = bar; b.x = xb_xcc_id(); b.st = st;
    if (threadIdx.x == 0) (void)xb_add(&bar[XB_XCNT(b.x)], 1u);
    return b;
}
__device__ __forceinline__ void xcd_barrier_complete(unsigned* bar, unsigned x, unsigned& nloc, unsigned& nx) {
    const unsigned G = gridDim.x * gridDim.y * gridDim.z;
    unsigned sum, cnt, mine, sp = 0u;
    for (;;) {
        sum = 0u; cnt = 0u; mine = 0u;
#pragma unroll
        for (unsigned j = 0; j < 16; ++j) { const unsigned c = xb_ld(&bar[XB_XCNT(j)]); sum += c; cnt += (c > 0u) ? 1u : 0u; mine = (j == x) ? c : mine; }
        if (sum == G) break;
        __builtin_amdgcn_s_sleep(1);
        if ((++sp & 255u) == 0u) { if (xb_ld(&bar[XB_TMO])) break; if (sp > XB_SPIN_CAP) { atomicAdd(&bar[XB_TMO], 1u); break; } }
    }
    nloc = mine > 0u ? mine : 1u; nx = cnt > 0u ? cnt : 1u;
}
__device__ __forceinline__ void xcd_barrier(const XcdBarrier& b) {
    asm volatile("s_waitcnt vmcnt(0)" ::: "memory");
    __syncthreads();
    if (threadIdx.x == 0) {
        unsigned* bar = b.bar;
        __builtin_amdgcn_s_waitcnt(0);
        unsigned nloc = b.st[0], nx = b.st[1];
        if (nloc == 0u) { xcd_barrier_complete(bar, b.x, nloc, nx); b.st[0] = nloc; b.st[1] = nx; }
        const unsigned old = xb_add(&bar[XB_XSUB(b.x)], 1u);
        const unsigned gen = old / nloc;
        if (old + 1u == (gen + 1u) * nloc) {
            __builtin_amdgcn_fence(__ATOMIC_RELEASE, "agent");
            asm volatile("s_waitcnt vmcnt(0)" ::: "memory");
            const unsigned og = xb_add(&bar[XB_TOP], 1u);
            const unsigned tg = og / nx;
            if (og + 1u == (tg + 1u) * nx) xb_add(&bar[XB_TOPGEN], 1u);
            else XB_SPIN(xb_ld(&bar[XB_TOPGEN]) == tg, bar);
            __builtin_amdgcn_fence(__ATOMIC_ACQUIRE, "agent");
            xb_add(&bar[XB_XGEN(b.x)], 1u);
            asm volatile("s_waitcnt vmcnt(0)" ::: "memory");
        } else {
            XB_SPIN(xb_ld(&bar[XB_XGEN(b.x)]) == gen, bar);
            __builtin_amdgcn_fence(__ATOMIC_ACQUIRE, "agent");
            asm volatile("s_waitcnt vmcnt(0)" ::: "memory");
        }
    }
    __syncthreads();
}

struct Frame {
    LAS unsigned char* lds;
    int tid, lane, wave, vcu, G;
    const float* in[24]; float* out; unsigned char* ws;
};
#define IN_X 0
#define IN_MEM 1
#define IN_GMIX 2
#define IN_WIN 3
#define IN_CONVW 4
#define IN_ALOG 5
#define IN_DTB 6
#define IN_GDOUT 7
#define IN_GAOUT 8
#define IN_WOUT 9
#define IN_GCROSS 10
#define IN_GMEM 11
#define IN_WQ 12
#define IN_WKV 13
#define IN_WO 14
#define IN_GMOE 15
#define IN_WGROUP 16
#define IN_BGROUP 17
#define IN_WEXPERT 18
#define IN_BEXPERT 19
#define IN_WGATE 20
#define IN_WUP 21
#define IN_WDOWN 22
#define IN_GFINAL 23
template <bool RMAP>
__device__ __forceinline__ void p0_transpose_item(const float* W, int ldw, int k0, int n0, bf16* WT, int ldt, int drow0, const float* gain, LAS float* scr, int lane) {
#pragma unroll 8
    for (int i = 0; i < 32; ++i) { const int kk = 2 * i + (lane >> 5); scr[kk * 33 + (lane & 31)] = W[(size_t)(k0 + kk) * ldw + n0 + (lane & 31)]; }
    asm volatile("s_waitcnt lgkmcnt(0)" ::: "memory");
    const int c = lane & 7;
    float g8[8];
#pragma unroll
    for (int e = 0; e < 8; ++e) g8[e] = gain ? gain[k0 + 8 * c + e] : 1.f;
#pragma unroll
    for (int j = 0; j < 4; ++j) { const int n = (lane >> 3) + 8 * j; const LAS float* s = scr + (8 * c) * 33 + n;
        u32x4 o; o.x = pk2(s[0 * 33] * g8[0], s[1 * 33] * g8[1]); o.y = pk2(s[2 * 33] * g8[2], s[3 * 33] * g8[3]); o.z = pk2(s[4 * 33] * g8[4], s[5 * 33] * g8[5]); o.w = pk2(s[6 * 33] * g8[6], s[7 * 33] * g8[7]);
        const int dr = drow0 + (RMAP ? (32 * (n >> 4) + (n & 15)) : n);
        *(u32x4*)(WT + (size_t)dr * ldt + k0 + 8 * c) = o; }
    asm volatile("s_waitcnt lgkmcnt(0)" ::: "memory");
}


struct TItem { const float* src; const float* gain; bf16* dst; int ldw, ldt, rmap; };
__device__ __forceinline__ void titem_load(const TItem& it, int lane, f32x4 (&v)[8]) {
#pragma unroll
    for (int i = 0; i < 8; ++i) v[i] = *(const f32x4*)(it.src + (size_t)(8 * i + (lane >> 3)) * it.ldw + 4 * (lane & 7));
}
__device__ __forceinline__ void titem_store(const TItem& it, int lane, LAS float* scr, const f32x4 (&v)[8]) {
#pragma unroll
    for (int i = 0; i < 8; ++i) { LAS float* d = scr + (8 * i + (lane >> 3)) * 33 + 4 * (lane & 7); d[0] = v[i][0]; d[1] = v[i][1]; d[2] = v[i][2]; d[3] = v[i][3]; }
    asm volatile("s_waitcnt lgkmcnt(0)" ::: "memory");
    const int c = lane & 7;
    float g8[8];
#pragma unroll
    for (int e = 0; e < 8; ++e) g8[e] = it.gain ? it.gain[8 * c + e] : 1.f;
#pragma unroll
    for (int j = 0; j < 4; ++j) { const int n = (lane >> 3) + 8 * j; const LAS float* sp = scr + (8 * c) * 33 + n;
        u32x4 o; o.x = pk2(sp[0 * 33] * g8[0], sp[1 * 33] * g8[1]); o.y = pk2(sp[2 * 33] * g8[2], sp[3 * 33] * g8[3]); o.z = pk2(sp[4 * 33] * g8[4], sp[5 * 33] * g8[5]); o.w = pk2(sp[6 * 33] * g8[6], sp[7 * 33] * g8[7]);
        const int dr = it.rmap ? (32 * (n >> 4) + (n & 15)) : n;
        *(u32x4*)(it.dst + (size_t)dr * it.ldt + 8 * c) = o; }
    asm volatile("s_waitcnt lgkmcnt(0)" ::: "memory");
}
__device__ __forceinline__ TItem mk_item(const float* W, int ldw, int k0, int n0, bf16* WT, int ldt, int drow0, const float* gain, int rmap) {
    TItem t; t.src = W + (size_t)k0 * ldw + n0; t.gain = gain ? gain + k0 : nullptr; t.dst = WT + (size_t)drow0 * ldt + k0; t.ldw = ldw; t.ldt = ldt; t.rmap = rmap; return t;
}
constexpr int TI_IN = 32 * 224, TI_OUT = 32 * 64, TI_Q = 32 * 16, TI_KV = 32 * 32, TI_O = 8 * 64, TI_E = 512;
constexpr int TI_NDENSE = TI_IN + TI_OUT + TI_Q + TI_KV + TI_O, TI_NMOE = NEXP * 3 * TI_E;
constexpr int TI_SPLIT0 = (TI_NMOE * 45 / 100) & ~7, TI_SPLIT1 = (TI_NMOE * 53 / 100) & ~7, TI_SPLIT2 = (TI_NMOE * 73 / 100) & ~7;
__device__ __forceinline__ TItem dense_item(Frame& F, int r) {
    unsigned char* ws = F.ws;
    if (r < TI_IN) return mk_item(F.in[IN_WIN], LDWIN, 64 * (r / 224), 32 * (r % 224), (bf16*)(ws + WS_WIN), D, 32 * (r % 224), nullptr, 0); r -= TI_IN;
    if (r < TI_OUT) return mk_item(F.in[IN_WOUT], D, 64 * (r / 64), 32 * (r % 64), (bf16*)(ws + WS_WOUT), D, 32 * (r % 64), nullptr, 0); r -= TI_OUT;
    if (r < TI_Q) return mk_item(F.in[IN_WQ], 512, 64 * (r / 16), 32 * (r % 16), (bf16*)(ws + WS_WQ), D, 32 * (r % 16), F.in[IN_GCROSS], 0); r -= TI_Q;
    if (r < TI_KV) return mk_item(F.in[IN_WKV], 1024, 64 * (r / 32), 32 * (r % 32), (bf16*)(ws + WS_WKV), D, 32 * (r % 32), nullptr, 0); r -= TI_KV;
    return mk_item(F.in[IN_WO], D, 64 * (r / 64), 32 * (r % 64), (bf16*)(ws + WS_WO), 512, 32 * (r % 64), nullptr, 0);
}
__device__ __forceinline__ TItem moe_item(Frame& F, int r) {
    unsigned char* ws = F.ws;
    const int e = r / (3 * TI_E), q = r % (3 * TI_E), which = q / TI_E, ii = q % TI_E;
    if (which == 0) return mk_item(F.in[IN_WGATE] + (size_t)e * D * DE, DE, 64 * (ii / 16), 32 * (ii % 16), (bf16*)(ws + WS_WGU) + (size_t)e * 1024 * D, D, 64 * (ii % 16), F.in[IN_GMOE], 1);
    if (which == 1) return mk_item(F.in[IN_WUP] + (size_t)e * D * DE, DE, 64 * (ii / 16), 32 * (ii % 16), (bf16*)(ws + WS_WGU) + (size_t)e * 1024 * D, D, 64 * (ii % 16) + 16, F.in[IN_GMOE], 1);
    return mk_item(F.in[IN_WDOWN] + (size_t)e * DE * D, D, 64 * (ii / 64), 32 * (ii % 64), (bf16*)(ws + WS_WD) + (size_t)e * D * DE, DE, 32 * (ii % 64), nullptr, 0);
}
template <bool MOE>
__device__ __forceinline__ void transpose_items(Frame& F, int first, int end, int stride, LAS float* scr) {
    int it = first; if (it >= end) return;
    TItem A = MOE ? moe_item(F, it) : dense_item(F, it), B = A; f32x4 va[8], vb[8];
    titem_load(A, F.lane, va);
    for (;;) {
        int nx = it + stride;
        if (nx < end) { B = MOE ? moe_item(F, nx) : dense_item(F, nx); titem_load(B, F.lane, vb); }
        titem_store(A, F.lane, scr, va);
        it = nx; if (it >= end) break;
        nx = it + stride;
        if (nx < end) { A = MOE ? moe_item(F, nx) : dense_item(F, nx); titem_load(A, F.lane, va); }
        titem_store(B, F.lane, scr, vb);
        it = nx; if (it >= end) break;
    }
}

__device__ __forceinline__ void convert_from_queue(Frame& F, int end, LAS float* scr) {
    unsigned* q = (unsigned*)(F.ws + WS_CTL) + CW_CONVQ;
    for (;;) {
        unsigned base = 0;
        if (F.lane == 0) base = __hip_atomic_fetch_add(q, 16u, __ATOMIC_RELAXED, __HIP_MEMORY_SCOPE_AGENT);
        base = (unsigned)__builtin_amdgcn_readfirstlane((int)base);
        if ((int)base >= end) break;
        const int e2 = (int)base + 16 < end ? (int)base + 16 : end;
        transpose_items<true>(F, (int)base, e2, 1, scr);
    }
}

__device__ __forceinline__ void p0_prologue(Frame& F) {
    unsigned char* ws = F.ws;
    const int gw = F.vcu * 8 + F.wave, NGW = F.G * 8;
    __syncthreads();
    {
        LAS float* T = (LAS float*)F.lds;
        const float* win = F.in[IN_WIN];
        for (int k = F.tid; k < D; k += 512) {
            const f32x4* src = (const f32x4*)(win + (size_t)k * LDWIN + NPROJ);
            const f32x4 a = src[0], b = src[1], c = src[2], d = src[3];
            T[0 * D + k] = a[0]; T[1 * D + k] = a[1]; T[2 * D + k] = a[2]; T[3 * D + k] = a[3];
            T[4 * D + k] = b[0]; T[5 * D + k] = b[1]; T[6 * D + k] = b[2]; T[7 * D + k] = b[3];
            T[8 * D + k] = c[0]; T[9 * D + k] = c[1]; T[10 * D + k] = c[2]; T[11 * D + k] = c[3];
            T[12 * D + k] = d[0]; T[13 * D + k] = d[1]; T[14 * D + k] = d[2]; T[15 * D + k] = d[3];
        }
        __syncthreads();
        const float* gm = F.in[IN_GMIX]; bf16* XN = (bf16*)(ws + WS_XN); float* BA = (float*)(ws + WS_BA);
        f32x4 gv[8];
#pragma unroll
        for (int j = 0; j < 8; ++j) gv[j] = *(const f32x4*)(gm + 4 * F.lane + 256 * j);
        for (int row = gw; row < S; row += NGW) {
            const float* xr = F.in[IN_X] + (size_t)row * D;
            f32x4 v[8]; float ss = 0.f;
#pragma unroll
            for (int j = 0; j < 8; ++j) { v[j] = *(const f32x4*)(xr + 4 * F.lane + 256 * j); ss += (v[j][0] * v[j][0] + v[j][1] * v[j][1]) + (v[j][2] * v[j][2] + v[j][3] * v[j][3]); }
            const float rstd = __builtin_amdgcn_rsqf(wave_sum_dpp(ss) * (1.f / D) + EPS);
#pragma unroll
            for (int j = 0; j < 8; ++j) { v[j] = v[j] * rstd * gv[j]; u32x2 w; w.x = pk2(v[j][0], v[j][1]); w.y = pk2(v[j][2], v[j][3]); *(u32x2*)(XN + (size_t)row * D + 4 * F.lane + 256 * j) = w; }
            float myo = 0.f;
#pragma unroll 1
            for (int o = 0; o < 16; ++o) { float a = 0.f;
#pragma unroll
                for (int j = 0; j < 8; ++j) { const f32x4 t = *(const LAS f32x4*)(T + o * D + 4 * F.lane + 256 * j); a += (v[j][0] * t[0] + v[j][1] * t[1]) + (v[j][2] * t[2] + v[j][3] * t[3]); }
                a = wave_sum_dpp(a); if (F.lane == o) myo = a; }
            if (F.lane < 16) BA[(size_t)row * 16 + F.lane] = myo;
        }
        __syncthreads();
    }
    {
        const float* gm = F.in[IN_GMEM]; bf16* MEMN = (bf16*)(ws + WS_MEMN);
        for (int row = gw; row < NMEM; row += NGW) {
            const float* xr = F.in[IN_MEM] + (size_t)row * D;
            f32x4 v[8]; float ss = 0.f;
#pragma unroll
            for (int j = 0; j < 8; ++j) { v[j] = *(const f32x4*)(xr + 4 * F.lane + 256 * j); ss += (v[j][0] * v[j][0] + v[j][1] * v[j][1]) + (v[j][2] * v[j][2] + v[j][3] * v[j][3]); }
            const float rstd = __builtin_amdgcn_rsqf(wave_sum(ss) * (1.f / D) + EPS);
#pragma unroll
            for (int j = 0; j < 8; ++j) { const f32x4 g = *(const f32x4*)(gm + 4 * F.lane + 256 * j); const f32x4 o = v[j] * rstd * g; u32x2 w; w.x = pk2(o[0], o[1]); w.y = pk2(o[2], o[3]); *(u32x2*)(MEMN + (size_t)row * D + 4 * F.lane + 256 * j) = w; }
        }
    }
    {
        bf16* WR = (bf16*)(ws + WS_WR); const float* gmoe = F.in[IN_GMOE]; const float* wg = F.in[IN_WGROUP]; const float* we = F.in[IN_WEXPERT];
        for (int idx = F.vcu * 512 + F.tid; idx < 256 * 256; idx += F.G * 512) { const int n = idx >> 8, k = (idx & 255) * 8; float v[8];
#pragma unroll
            for (int e = 0; e < 8; ++e) { float w = 0.f; if (n < 8) w = wg[(size_t)(k + e) * 8 + n]; else if (n < 72) w = we[(size_t)(k + e) * 64 + (n - 8)]; v[e] = w * gmoe[k + e]; }
            u32x4 o; o.x = pk2(v[0], v[1]); o.y = pk2(v[2], v[3]); o.z = pk2(v[4], v[5]); o.w = pk2(v[6], v[7]);
            *(u32x4*)(WR + (size_t)n * D + k) = o; }
    }
    transpose_items<false>(F, gw, TI_NDENSE, NGW, (LAS float*)(F.lds + F.wave * 16384));
}
#define MFMA32(a, b, c) __builtin_amdgcn_mfma_f32_32x32x16_bf16((a), (b), (c), 0, 0, 0)
#define MFMA16(a, b, c) __builtin_amdgcn_mfma_f32_16x16x32_bf16((a), (b), (c), 0, 0, 0)
typedef short v4i16_t __attribute__((ext_vector_type(4)));
__device__ __forceinline__ unsigned offb(unsigned row, unsigned ch) { return 256u * row + 16u * (ch ^ (((row & 3u) << 2) | ((row >> 2) & 3u))); }
__device__ __forceinline__ unsigned off128(unsigned row, unsigned ch) { return 128u * row + 16u * (ch ^ (row & 7u)); }
__device__ __forceinline__ int crow(int r, int h) { return (r & 3) + 8 * (r >> 2) + 4 * h; }
__device__ __forceinline__ s16x4 vtr(const LAS unsigned char* p) { return __builtin_bit_cast(s16x4, __builtin_amdgcn_ds_read_tr16_b64_v4i16((LAS v4i16_t*)p)); }

template <int MODE>
__device__ __forceinline__ void attn_wave(LAS unsigned char* wl, int lane, const bf16* qrow0, long qstride, const bf16* kbase, const bf16* vbase, long kvstride,
                                          int k_first, int ntiles, float c1, float b2, float rq, bf16* orow0, long ostride, float* lse0, long lsestride) {
    const int c = lane & 31, h = lane >> 5;
    bf16x8 qf[8];
#pragma unroll
    for (int s = 0; s < 8; ++s) qf[s] = *(const bf16x8*)(qrow0 + (long)c * qstride + 16 * s + 8 * h);
    f32x16 O[4];
#pragma unroll
    for (int dt = 0; dt < 4; ++dt)
#pragma unroll
        for (int i = 0; i < 16; ++i) O[dt][i] = 0.f;
    float m = -1e30f, l = 0.f;
    const int q4 = (lane & 15) >> 2, p4 = lane & 3, blk = (lane >> 4) & 1;
    int t0 = 0; while (t0 < ntiles && k_first + 32 * t0 < 0) ++t0;
    const int sr0 = lane >> 4, sch = lane & 15;
    const bf16* kp = kbase + (long)(k_first + 32 * t0 + sr0) * kvstride + sch * 8;
    const bf16* vp = vbase + (long)(k_first + 32 * t0 + sr0) * kvstride + sch * 8;
    const long rstep = 4 * kvstride, tstep = 32 * kvstride;
    unsigned lofs[8];
#pragma unroll
    for (int i = 0; i < 8; ++i) lofs[i] = offb(sr0 + 4 * i, sch);
    u32x4 kreg[8], vreg[8];
    if (t0 < ntiles) {
#pragma unroll
        for (int i = 0; i < 8; ++i) kreg[i] = *(const u32x4*)(kp + i * rstep);
    }
    for (int t = t0; t < ntiles; ++t) {
#pragma unroll
        for (int i = 0; i < 8; ++i) { vreg[i] = *(const u32x4*)(vp + i * rstep); *(LAS u32x4*)(wl + lofs[i]) = kreg[i]; }
        kp += tstep; vp += tstep;
        if (t + 1 < ntiles) {
#pragma unroll
            for (int i = 0; i < 8; ++i) kreg[i] = *(const u32x4*)(kp + i * rstep);
        }
        asm volatile("s_waitcnt lgkmcnt(0)" ::: "memory");
        f32x16 acc;
#pragma unroll
        for (int i = 0; i < 16; ++i) acc[i] = 0.f;
#pragma unroll
        for (int s = 0; s < 8; ++s) { const bf16x8 kf = *(const LAS bf16x8*)(wl + offb(c, 2 * s + h)); acc = MFMA32(kf, qf[s], acc); }
        float tmax = -__builtin_inff();
        if (MODE == 0) { const int dbase = 128 - 32 * t + c;
#pragma unroll
            for (int i = 0; i < 16; ++i) { const int dist = dbase - crow(i, h); float sc = acc[i] * c1 - b2 * (float)dist; if ((unsigned)dist > 128u) sc = -__builtin_inff(); acc[i] = sc; tmax = fmaxf(tmax, sc); }
        } else { const float cc = c1 * rq;
#pragma unroll
            for (int i = 0; i < 16; ++i) { const float sc = acc[i] * cc; acc[i] = sc; tmax = fmaxf(tmax, sc); }
        }
        tmax = fmaxf(tmax, __shfl_xor(tmax, 32));
        const float mn = fmaxf(m, tmax), alpha = __builtin_amdgcn_exp2f(m - mn);
        float rs = 0.f;
#pragma unroll
        for (int i = 0; i < 16; ++i) { acc[i] = __builtin_amdgcn_exp2f(acc[i] - mn); rs += acc[i]; }
        rs += __shfl_xor(rs, 32);
        l = l * alpha + rs; m = mn;
#pragma unroll
        for (int dt = 0; dt < 4; ++dt)
#pragma unroll
            for (int i = 0; i < 16; ++i) O[dt][i] *= alpha;
#pragma unroll
        for (int i = 0; i < 8; ++i) *(LAS u32x4*)(wl + 8192 + lofs[i]) = vreg[i];
        asm volatile("s_waitcnt lgkmcnt(0)" ::: "memory");
        bf16x8 pf[2];
#pragma unroll
        for (int ks = 0; ks < 2; ++ks) { u32x4 w = {pk2(acc[8 * ks + 0], acc[8 * ks + 1]), pk2(acc[8 * ks + 2], acc[8 * ks + 3]), pk2(acc[8 * ks + 4], acc[8 * ks + 5]), pk2(acc[8 * ks + 6], acc[8 * ks + 7])}; pf[ks] = __builtin_bit_cast(bf16x8, w); }
#pragma unroll
        for (int dt = 0; dt < 4; ++dt)
#pragma unroll
            for (int ks = 0; ks < 2; ++ks) {
                const s16x4 lo = vtr(wl + 8192 + offb(16 * ks + 4 * h + q4, 4 * dt + 2 * blk + (p4 >> 1)) + 8 * (p4 & 1));
                const s16x4 hi = vtr(wl + 8192 + offb(16 * ks + 8 + 4 * h + q4, 4 * dt + 2 * blk + (p4 >> 1)) + 8 * (p4 & 1));
                const bf16x8 vf = __builtin_shufflevector(lo, hi, 0, 1, 2, 3, 4, 5, 6, 7);
                O[dt] = MFMA32(vf, pf[ks], O[dt]);
            }
    }
    const float inv = 1.f / l;
#pragma unroll
    for (int dt = 0; dt < 4; ++dt)
#pragma unroll
        for (int g = 0; g < 4; ++g) { u32x2 w; w.x = pk2(O[dt][4 * g] * inv, O[dt][4 * g + 1] * inv); w.y = pk2(O[dt][4 * g + 2] * inv, O[dt][4 * g + 3] * inv);
            *(u32x2*)(orow0 + (long)c * ostride + 32 * dt + 8 * g + 4 * h) = w; }
    if (MODE == 0) { if (h == 0) lse0[(long)c * lsestride] = (m + __builtin_amdgcn_logf(l)) * LN2; }
}

__device__ __forceinline__ void dilated_unit(Frame& F, int wu) {
    const int pat = wu >> 12, hd = (wu >> 9) & 7, blkq = wu & 511;
    const int d = pat == 0 ? 1 : (pat == 1 ? 4 : 16), L = S / d, nbq = L / 32;
    const int res = blkq / nbq, q0 = (blkq % nbq) * 32;
    const bf16* QKVA = (const bf16*)(F.ws + WS_QKVA);
    const long rs_ = (long)d * 3072;
    const bf16* base = QKVA + (long)res * 3072 + hd * 128;
    const float slope = __builtin_amdgcn_exp2f(-(float)(hd + 1));
    bf16* AO = (bf16*)(F.ws + WS_ATTO) + (size_t)pat * S * 1024 + (long)res * 1024 + hd * 128;
    float* LSE = (float*)(F.ws + WS_LSE) + (size_t)pat * S * 8 + (long)res * 8 + hd;
    attn_wave<0>(F.lds + F.wave * WAVE_LDS, F.lane, base + (long)q0 * rs_, rs_, base + 1024, base + 2048, rs_, q0 - 128, 5,
                 0.08838834764831845f * LOG2E, slope * (float)d * LOG2E, 1.f, AO + (long)q0 * d * 1024, (long)d * 1024, LSE + (long)q0 * d * 8, (long)d * 8);
}

__device__ __forceinline__ void cross_unit(Frame& F, int unit) {
    const int panel = unit >> 2, hd = unit & 3, row0 = panel * 256 + F.wave * 32;
    const bf16* QM = (const bf16*)(F.ws + WS_QMEM); const bf16* KV = (const bf16*)(F.ws + WS_KVMEM); const float* SSQ = (const float*)(F.ws + WS_SSQ1);
    const int qrow = row0 + (F.lane & 31);
    float ss = 0.f;
#pragma unroll
    for (int i = 0; i < 8; ++i) { const f32x4 v = *(const f32x4*)(SSQ + (size_t)qrow * 32 + 4 * i); ss += (v[0] + v[1]) + (v[2] + v[3]); }
    const float rq = __builtin_amdgcn_rsqf(ss * (1.f / D) + EPS);
    attn_wave<1>(F.lds + F.wave * WAVE_LDS, F.lane, QM + (size_t)row0 * 512 + hd * 128, 512, KV + hd * 128, KV + 512 + hd * 128, 1024, 0, 8,
                 0.08838834764831845f * LOG2E, 0.f, rq, (bf16*)(F.ws + WS_OMEM) + (size_t)row0 * 512 + hd * 128, 512, nullptr, 0);
}

__device__ __forceinline__ void merge_token(Frame& F, int t) {
    const int lane = F.lane, hd = lane >> 3, col = lane * 16;
    const bf16* AO = (const bf16*)(F.ws + WS_ATTO); const float* LSE = (const float*)(F.ws + WS_LSE);
    bf16* MIX = (bf16*)(F.ws + WS_MIX);
    float l0 = LSE[(size_t)t * 8 + hd], l1 = LSE[(size_t)S * 8 + (size_t)t * 8 + hd], l2 = LSE[(size_t)2 * S * 8 + (size_t)t * 8 + hd];
    const float mx = fmaxf(l0, fmaxf(l1, l2));
    float w0 = __expf(l0 - mx), w1 = __expf(l1 - mx), w2 = __expf(l2 - mx); const float wi = 1.f / (w0 + w1 + w2); w0 *= wi; w1 *= wi; w2 *= wi;
    float a[16]; float ss = 0.f;
#pragma unroll
    for (int hlf = 0; hlf < 2; ++hlf) {
        const bf16x8 o0 = *(const bf16x8*)(AO + (size_t)t * 1024 + col + 8 * hlf), o1 = *(const bf16x8*)(AO + ((size_t)S + t) * 1024 + col + 8 * hlf), o2 = *(const bf16x8*)(AO + ((size_t)2 * S + t) * 1024 + col + 8 * hlf);
#pragma unroll
        for (int e = 0; e < 8; ++e) { const float v = w0 * bf2f((unsigned short)o0[e]) + w1 * bf2f((unsigned short)o1[e]) + w2 * bf2f((unsigned short)o2[e]); a[8 * hlf + e] = v; ss += v * v; }
    }
    const float rstd = __builtin_amdgcn_rsqf(wave_sum(ss) * (1.f / 1024.f) + EPS);
    const float* ga = F.in[IN_GAOUT];
    {
        u32x4 w0_, w1_; float g[16];
#pragma unroll
        for (int e = 0; e < 16; e += 4) { const f32x4 gg = *(const f32x4*)(ga + col + e); g[e] = gg[0]; g[e + 1] = gg[1]; g[e + 2] = gg[2]; g[e + 3] = gg[3]; }
        w0_.x = pk2(a[0] * rstd * g[0], a[1] * rstd * g[1]); w0_.y = pk2(a[2] * rstd * g[2], a[3] * rstd * g[3]); w0_.z = pk2(a[4] * rstd * g[4], a[5] * rstd * g[5]); w0_.w = pk2(a[6] * rstd * g[6], a[7] * rstd * g[7]);
        w1_.x = pk2(a[8] * rstd * g[8], a[9] * rstd * g[9]); w1_.y = pk2(a[10] * rstd * g[10], a[11] * rstd * g[11]); w1_.z = pk2(a[12] * rstd * g[12], a[13] * rstd * g[13]); w1_.w = pk2(a[14] * rstd * g[14], a[15] * rstd * g[15]);
        *(u32x4*)(MIX + (size_t)t * 2048 + col) = w0_; *(u32x4*)(MIX + (size_t)t * 2048 + col + 8) = w1_;
    }
}
__device__ __forceinline__ int perm32pos(int x) { return (x & ~31) + 8 * ((x >> 2) & 3) + 4 * ((x >> 4) & 1) + (x & 3); }

template <class Fn>
__device__ __forceinline__ void conv_col(const bf16* src, int t0, const float* cw  , Fn&& fn) {
    const float w0 = cw[0], w1 = cw[3072], w2 = cw[2 * 3072], w3 = cw[3 * 3072];
    float xm3 = 0.f, xm2 = 0.f, xm1 = 0.f;
    if (t0 > 0) { xm3 = bf2f(src[-3 * 3072]); xm2 = bf2f(src[-2 * 3072]); xm1 = bf2f(src[-1 * 3072]); }
    const bf16* p = src;
#pragma unroll
    for (int c = 0; c < 64; ++c) { const float xc = bf2f(*p); p += 3072; asm("" : "+v"(p));
        const float v = (w0 * xm3 + w1 * xm2) + (w2 * xm1 + w3 * xc);
        fn(c, v * __builtin_amdgcn_rcpf(1.f + __expf(-v))); xm3 = xm2; xm2 = xm1; xm1 = xc; }
}


template <int OFF> __device__ __forceinline__ void lds_ld128(unsigned base, f32x4& d) { asm volatile("ds_read_b128 %0, %1 offset:%2" : "=v"(d) : "v"(base), "i"(OFF)); }
template <int C, int H, int... K> __device__ __forceinline__ void subst_issue(unsigned base, f32x4 (&buf)[4], std::integer_sequence<int, K...>) { (lds_ld128<C * 256 + 64 * H + 16 * K>(base, buf[K]), ...); }
template <int C, int H> struct SubstSeg {
    static constexpr int lo = 16 * H, hi = (C < 16 * H + 16) ? C : 16 * H + 16, nvec = (hi - lo + 3) / 4;
    static constexpr bool last_of_row = (16 * H + 16 >= C);
    static constexpr int NC = last_of_row ? C + 1 : C, NH = last_of_row ? 0 : H + 1;
};
template <int C, int H> __device__ __forceinline__ void subst_seg(unsigned base, float (&x)[64], float a, f32x4 (&cur)[4], f32x4 (&nxt)[4]) {
    using Sg = SubstSeg<C, H>;
    if constexpr (Sg::NC < 64) subst_issue<Sg::NC, Sg::NH>(base, nxt, std::make_integer_sequence<int, SubstSeg<Sg::NC, Sg::NH>::nvec>{});
#pragma unroll
    for (int sidx = Sg::lo; sidx < Sg::hi; ++sidx) a -= cur[(sidx - Sg::lo) >> 2][sidx & 3] * x[sidx];
    if constexpr (Sg::last_of_row) x[C] = a;
    if constexpr (Sg::NC < 64) { asm volatile("s_waitcnt lgkmcnt(0)" ::: "memory"); __builtin_amdgcn_sched_barrier(0);
        if constexpr (Sg::last_of_row) subst_seg<Sg::NC, Sg::NH>(base, x, x[Sg::NC], nxt, cur); else subst_seg<Sg::NC, Sg::NH>(base, x, a, nxt, cur); }
}

__device__ __forceinline__ void delta_prep_unit(Frame& F, int cu, unsigned long long* TSW) {
#define PSTAMP(i) do { if (TS_A >= 0 && blockIdx.x == 0 && threadIdx.x == 0) __hip_atomic_store(TSW + (i), (unsigned long long)__builtin_amdgcn_s_memrealtime(), __ATOMIC_RELAXED, __HIP_MEMORY_SCOPE_AGENT); } while (0)
    PSTAMP(25);
    const int chunk = cu >> 3, hd = cu & 7, t0 = chunk * 64, lane = F.lane;
    LAS unsigned char* wsm = F.lds + PREP_SMALL_OFF + F.wave * 1280;
    LAS float* Am = (LAS float*)(F.lds + F.wave * WAVE_LDS);
    LAS float* gcs = (LAS float*)(wsm); LAS float* betas = (LAS float*)(wsm + 256); LAS float* rks = (LAS float*)(wsm + 512); LAS float* rqs = (LAS float*)(wsm + 768);
    unsigned char* ws = F.ws;
    const bf16* QKVD = (const bf16*)(ws + WS_QKVD); const float* BA = (const float*)(ws + WS_BA); const float* cw = F.in[IN_CONVW];
    bf16* QN = (bf16*)(ws + WS_QN); bf16* KN = (bf16*)(ws + WS_KN); bf16* QDEC = (bf16*)(ws + WS_QDEC); bf16* KDT = (bf16*)(ws + WS_KDT); bf16* WW = (bf16*)(ws + WS_WW);
    float* UT = (float*)(ws + WS_UT); bf16* QKM = (bf16*)(ws + WS_QKM); float* GLAST = (float*)(ws + WS_GLAST);
    float glast;
    {
        const float a = BA[(size_t)(t0 + lane) * 16 + 8 + hd], b = BA[(size_t)(t0 + lane) * 16 + hd];
        const float beta = 1.f / (1.f + __expf(-b));
        const float x = a + F.in[IN_DTB][hd]; const float sp = x > 20.f ? x : log1pf(__expf(x));
        float gc = -__expf(F.in[IN_ALOG][hd]) * sp;
#pragma unroll
        for (int o = 1; o < 64; o <<= 1) { const float t = __shfl_up(gc, o); if (lane >= o) gc += t; }
        glast = __shfl(gc, 63);
        gcs[lane] = gc; betas[lane] = beta;
        if (lane == 0) GLAST[cu] = glast;
    }
#ifndef PREP_PARTS
#define PREP_PARTS 15
#endif
    if (PREP_PARTS & 1) {
#pragma unroll 1
    for (int sec = 0; sec < 2; ++sec) {
        float ss[64];
#pragma unroll
        for (int c = 0; c < 64; ++c) ss[c] = 0.f;
#pragma unroll 1
        for (int hh = 0; hh < 2; ++hh) { const int col = sec * 1024 + hd * 128 + 64 * hh + lane;
            conv_col(QKVD + (size_t)t0 * 3072 + col, t0, cw + col, [&](int c, float y) { ss[c] += y * y; }); }
        float myr = 0.f;
#pragma unroll
        for (int c = 0; c < 64; ++c) { const float tot = wave_sum_dpp(ss[c]); if (lane == c) myr = __builtin_amdgcn_rsqf(tot + EPS); }
        if (sec == 0) rqs[lane] = myr; else rks[lane] = myr;
    }
    }
    asm volatile("s_waitcnt lgkmcnt(0)" ::: "memory");
    PSTAMP(26);
#ifndef PP
#define PP 15
#endif
    if (PP & 2) {
#pragma unroll 1
    for (int hh = 0; hh < 2; ++hh) {
        const int j = 64 * hh + lane;
        { const int col = hd * 128 + j; const int pj = hd * 128 + perm32pos(j); float y[64];
          conv_col(QKVD + (size_t)t0 * 3072 + col, t0, cw + col, [&](int c, float v) { y[c] = v; });
          bf16* pq = QN + (size_t)t0 * 1024 + hd * 128 + j; bf16* pd = QDEC + (size_t)t0 * 1024 + pj;
#pragma unroll
          for (int c = 0; c < 64; ++c) { const float qn = y[c] * rqs[c];
              *pq = (bf16)(pk2(qn, 0.f) & 0xffffu); *pd = (bf16)(pk2(qn * 0.08838834764831845f * __expf(gcs[c]), 0.f) & 0xffffu);
              pq += 1024; pd += 1024; asm("" : "+v"(pq), "+v"(pd)); } }
        { const int col = 1024 + hd * 128 + j; float y[64];
          conv_col(QKVD + (size_t)t0 * 3072 + col, t0, cw + col, [&](int c, float v) { y[c] = v; });
          unsigned kdw[32];
          bf16* pk = KN + (size_t)t0 * 1024 + hd * 128 + j;
#pragma unroll
          for (int c = 0; c < 64; c += 2) { const float k0 = y[c] * rks[c], k1 = y[c + 1] * rks[c + 1];
              *pk = (bf16)(pk2(k0, 0.f) & 0xffffu); pk += 1024; asm("" : "+v"(pk)); *pk = (bf16)(pk2(k1, 0.f) & 0xffffu); pk += 1024; asm("" : "+v"(pk));
              kdw[perm32pos(c) >> 1] = pk2(k0 * __expf(glast - gcs[c]), k1 * __expf(glast - gcs[c + 1])); }
          u32x4* dst = (u32x4*)(KDT + ((size_t)cu * 128 + j) * 64);
#pragma unroll
          for (int q = 0; q < 8; ++q) dst[q] = (u32x4){kdw[4 * q], kdw[4 * q + 1], kdw[4 * q + 2], kdw[4 * q + 3]}; }
    }
    }
    asm volatile("s_waitcnt vmcnt(0)" ::: "memory");
    PSTAMP(27);
    if (PP & 4) {
    {
        const int r = lane & 31, h = lane >> 5;
        const int pl = 8 * ((r >> 2) & 3) + 4 * (r >> 4) + (r & 3);
        const bf16* knb = KN + (size_t)(t0 + r) * 1024 + hd * 128 + 8 * h; const bf16* qnb = QN + (size_t)(t0 + r) * 1024 + hd * 128 + 8 * h;
#pragma unroll 1
        for (int tile = 0; tile < 3; ++tile) { const int I = tile > 0 ? 1 : 0, J = tile > 1 ? 1 : 0;
            f32x16 ak, aq;
#pragma unroll
            for (int i = 0; i < 16; ++i) { ak[i] = 0.f; aq[i] = 0.f; }
#pragma unroll
            for (int s8 = 0; s8 < 8; ++s8) { const bf16x8 kI = *(const bf16x8*)(knb + (size_t)I * 32 * 1024 + 16 * s8), kJ = *(const bf16x8*)(knb + (size_t)J * 32 * 1024 + 16 * s8), qI = *(const bf16x8*)(qnb + (size_t)I * 32 * 1024 + 16 * s8);
                ak = MFMA32(kI, kJ, ak); aq = MFMA32(qI, kJ, aq); }
            const int sc = 32 * J + r; const float gs = gcs[sc];
#pragma unroll
            for (int i = 0; i < 16; ++i) { const int c = 32 * I + crow(i, h); const float dec = __expf(fminf(gcs[c] - gs, 0.f));
                Am[c * 64 + sc] = ak[i] * betas[c] * dec;
                const float qv = (sc <= c) ? aq[i] * 0.08838834764831845f * dec : 0.f;
                QKM[(size_t)cu * 4096 + c * 64 + 32 * J + pl] = (bf16)(pk2(qv, 0.f) & 0xffffu); }
        }
        asm volatile("s_waitcnt lgkmcnt(0)" ::: "memory");
#pragma unroll
        for (int i = 0; i < 16; ++i) QKM[(size_t)cu * 4096 + crow(i, h) * 64 + 32 + pl] = (bf16)0;
    }
    }
    PSTAMP(28);
    if (PP & 8) {
#pragma unroll 1
    for (int pass = 0; pass < 4; ++pass) {
        const int hh = pass & 1, j = 64 * hh + lane; float x[64];
        if (pass < 2) { const int col = 2048 + hd * 128 + j; conv_col(QKVD + (size_t)t0 * 3072 + col, t0, cw + col, [&](int c, float y) { x[c] = y * betas[c]; });
        } else { const bf16* pk = KN + (size_t)t0 * 1024 + hd * 128 + j;
#pragma unroll
            for (int c = 0; c < 64; ++c) { x[c] = bf2f(*pk) * betas[c] * __expf(gcs[c]); pk += 1024; asm("" : "+v"(pk)); }
        }
        { f32x4 ra[4], rb[4]; const unsigned abase = (unsigned)(size_t)Am;
          lds_ld128<256>(abase, ra[0]); asm volatile("s_waitcnt lgkmcnt(0)" ::: "memory"); __builtin_amdgcn_sched_barrier(0);
          subst_seg<1, 0>(abase, x, x[1], ra, rb); }
        if (pass < 2) { f32x4* dst = (f32x4*)(UT + ((size_t)cu * 128 + j) * 64);
#pragma unroll
            for (int q = 0; q < 16; ++q) dst[q] = (f32x4){x[4 * q], x[4 * q + 1], x[4 * q + 2], x[4 * q + 3]};
        } else { bf16* pw = WW + (size_t)t0 * 1024 + hd * 128 + perm32pos(j);
#pragma unroll
            for (int c = 0; c < 64; ++c) { *pw = (bf16)(pk2(x[c], 0.f) & 0xffffu); pw += 1024; asm("" : "+v"(pw)); }
        }
    }
    }
    asm volatile("s_waitcnt vmcnt(0) lgkmcnt(0)" ::: "memory");
    PSTAMP(29);
#undef PSTAMP
}

__device__ __forceinline__ void delta_scan(Frame& F, int hd, int half) {
    unsigned char* ws = F.ws; const int tid = F.tid, lane = F.lane, w = F.wave;
    const bf16* QDEC = (const bf16*)(ws + WS_QDEC); const bf16* KDT = (const bf16*)(ws + WS_KDT); const bf16* WW = (const bf16*)(ws + WS_WW);
    const float* UT = (const float*)(ws + WS_UT); const bf16* QKM = (const bf16*)(ws + WS_QKM); const float* GLAST = (const float*)(ws + WS_GLAST);
    float* OD = (float*)(ws + WS_ODELTA);
    constexpr int BUF = 57344;
    const int col = lane & 15, g = lane >> 4, col0 = half * 64 + 16 * (w & 3);
    f32x4 St[8];
#pragma unroll
    for (int i = 0; i < 8; ++i) St[i] = (f32x4){0.f, 0.f, 0.f, 0.f};
    u32x4 stg[7];
#define SCAN_LOAD(n) do { const int cu_ = (n) * 8 + hd; const size_t t0_ = (size_t)(n) * 64; \
        _Pragma("unroll") for (int k = 0; k < 7; ++k) { const int m_ = (tid + 512 * k) & 1023; \
            if (k < 2) stg[k] = *(const u32x4*)(WW + (t0_ + (m_ >> 4)) * 1024 + hd * 128 + (m_ & 15) * 8); \
            else if (k < 4) stg[k] = *(const u32x4*)(QDEC + (t0_ + (m_ >> 4)) * 1024 + hd * 128 + (m_ & 15) * 8); \
            else if (k < 6) stg[k] = *(const u32x4*)(KDT + ((size_t)cu_ * 128 + (m_ >> 3)) * 64 + (m_ & 7) * 8); \
            else stg[k] = *(const u32x4*)(QKM + (size_t)cu_ * 4096 + ((m_ & 511) >> 3) * 64 + (m_ & 7) * 8); } } while (0)
#define SCAN_STORE(b) do { LAS unsigned char* B_ = F.lds + (b) * BUF; \
        _Pragma("unroll") for (int k = 0; k < 7; ++k) { const int m_ = (tid + 512 * k) & 1023; \
            if (k < 2) *(LAS u32x4*)(B_ + offb(m_ >> 4, m_ & 15)) = stg[k]; \
            else if (k < 4) *(LAS u32x4*)(B_ + 16384 + offb(m_ >> 4, m_ & 15)) = stg[k]; \
            else if (k < 6) *(LAS u32x4*)(B_ + 32768 + off128(m_ >> 3, m_ & 7)) = stg[k]; \
            else *(LAS u32x4*)(B_ + 49152 + off128((m_ & 511) >> 3, m_ & 7)) = stg[k]; } } while (0)
    SCAN_LOAD(0); SCAN_STORE(0);
    __syncthreads();
    for (int n = 0; n < NCH; ++n) {
        const int cu = n * 8 + hd; const size_t t0 = (size_t)n * 64;
        if (n + 1 < NCH) SCAN_LOAD(n + 1);
        if (w < 4) {
            const LAS unsigned char* B = F.lds + (n & 1) * BUF;
            f32x4 ut[4];
#pragma unroll
            for (int rb = 0; rb < 4; ++rb) ut[rb] = *(const f32x4*)(UT + ((size_t)cu * 128 + col0 + col) * 64 + 16 * rb + 4 * g);
            const float dec = __expf(GLAST[cu]);
            bf16x8 sf[4];
#pragma unroll
            for (int ks = 0; ks < 4; ++ks) sf[ks] = pack8(St[2 * ks], St[2 * ks + 1]);
            f32x4 vn[4], o[4];
#pragma unroll
            for (int rb = 0; rb < 4; ++rb) { f32x4 a = (f32x4){0.f, 0.f, 0.f, 0.f}, q = (f32x4){0.f, 0.f, 0.f, 0.f};
#pragma unroll
                for (int ks = 0; ks < 4; ++ks) { const bf16x8 wf = *(const LAS bf16x8*)(B + offb(16 * rb + col, 4 * ks + g)); const bf16x8 qf = *(const LAS bf16x8*)(B + 16384 + offb(16 * rb + col, 4 * ks + g));
                    a = MFMA16(wf, sf[ks], a); q = MFMA16(qf, sf[ks], q); }
                vn[rb] = ut[rb] - a; o[rb] = q; }
            bf16x8 vf[2];
#pragma unroll
            for (int k2 = 0; k2 < 2; ++k2) vf[k2] = pack8(vn[2 * k2], vn[2 * k2 + 1]);
#pragma unroll
            for (int rb = 0; rb < 4; ++rb) {
#pragma unroll
                for (int k2 = 0; k2 < 2; ++k2) { const bf16x8 qk = *(const LAS bf16x8*)(B + 49152 + off128(16 * rb + col, 4 * k2 + g)); o[rb] = MFMA16(qk, vf[k2], o[rb]); }
#pragma unroll
                for (int i = 0; i < 4; ++i) OD[(t0 + 16 * rb + 4 * g + i) * 1024 + hd * 128 + col0 + col] = o[rb][i]; }
#pragma unroll
            for (int tt = 0; tt < 8; ++tt) { f32x4 s = St[tt] * dec;
#pragma unroll
                for (int k2 = 0; k2 < 2; ++k2) { const bf16x8 kd = *(const LAS bf16x8*)(B + 32768 + off128(16 * tt + col, 4 * k2 + g)); s = MFMA16(kd, vf[k2], s); }
                St[tt] = s; }
        }
        if (n + 1 < NCH) SCAN_STORE((n + 1) & 1);
        __syncthreads();
    }
#undef SCAN_LOAD
#undef SCAN_STORE
}

template <int NCW>
__device__ __forceinline__ void delta_scan2(Frame& F, int hd, int half) {
    unsigned char* ws = F.ws; const int lane = F.lane, w = F.wave;
    const bf16* KDT = (const bf16*)(ws + WS_KDT); const bf16* WW = (const bf16*)(ws + WS_WW);
    const float* UT = (const float*)(ws + WS_UT); const float* GLAST = (const float*)(ws + WS_GLAST);
    u32x4* SFR = (u32x4*)(ws + WS_SFRAG); u32x4* VFR = (u32x4*)(ws + WS_VFRAG);
    constexpr int BUF = 32768;
    LAS float* decs = (LAS float*)(F.lds + PREP_SMALL_OFF);
    if (F.tid < NCH) decs[F.tid] = __expf(GLAST[F.tid * 8 + hd]);
    __syncthreads();
    if (w >= 4) {
        const int lw = w - 4;
        unsigned voff[8];
#pragma unroll
        for (int i = 0; i < 8; ++i) { const int pce = lw * 8 + i;
            if (pce < 16) { const int pos = pce * 64 + lane, row = pos >> 4, chs = pos & 15, ch = chs ^ (((row & 3) << 2) | ((row >> 2) & 3)); voff[i] = (unsigned)(row * 1024 + ch * 8) * 2u; }
            else { const int pos = (pce - 16) * 64 + lane, row = pos >> 3, chs = pos & 7, ch = chs ^ (row & 7); voff[i] = (unsigned)(row * 64 + ch * 8) * 2u; } }
        const unsigned ldsb = (unsigned)(lw * 8) * 1024u;
#define SC_ISSUE(n) do { const int n_ = (n) < NCH ? (n) : NCH - 1; const char* src_ = lw < 2 ? (const char*)(WW + (size_t)n_ * 64 * 1024 + hd * 128) : (const char*)(KDT + ((size_t)(n_ * 8 + hd) * 128) * 64); \
        _Pragma("unroll") for (int i = 0; i < 8; ++i) __builtin_amdgcn_global_load_lds((const unsigned*)(src_ + voff[i]), (LAS unsigned*)(F.lds + ((n) & 3) * BUF + ldsb + i * 1024), 16, 0, 0); } while (0)
        SC_ISSUE(0); SC_ISSUE(1); SC_ISSUE(2);
        asm volatile("s_waitcnt vmcnt(16)" ::: "memory");
        __builtin_amdgcn_s_barrier();
        for (int n = 0; n < NCH; ++n) {
            SC_ISSUE(n + 3);
            asm volatile("s_waitcnt vmcnt(16)" ::: "memory");
            __builtin_amdgcn_s_barrier();
        }
        asm volatile("s_waitcnt vmcnt(0)" ::: "memory");
#undef SC_ISSUE
    } else if (w >= NCW) {
        for (int n = 0; n <= NCH; ++n) __builtin_amdgcn_s_barrier();
    } else {
        const int col = lane & 15, g = lane >> 4, sl = half * NCW + w, col0 = sl * 16;
        f32x4 St[8];
#pragma unroll
        for (int i = 0; i < 8; ++i) St[i] = (f32x4){0.f, 0.f, 0.f, 0.f};
        f32x4 utA[4], utB[4], utC[4], utD[4];
#define SC_UT(U, n) do { const int cu_ = ((n) < NCH ? (n) : NCH - 1) * 8 + hd; _Pragma("unroll") for (int rb = 0; rb < 4; ++rb) U[rb] = *(const f32x4*)(UT + ((size_t)cu_ * 128 + col0 + col) * 64 + 16 * rb + 4 * g); } while (0)
        SC_UT(utA, 0); SC_UT(utB, 1); SC_UT(utC, 2); SC_UT(utD, 3);
        __builtin_amdgcn_s_barrier();
#define SC_STEP(n, U) do { const int cu = (n) * 8 + hd; const LAS unsigned char* B = F.lds + ((n) & 3) * BUF; const float dec_ = decs[(n)]; \
            if (half == 0 && w == 0 && lane == 0) __hip_atomic_store((unsigned*)(ws + WS_CTL) + CW_PROG + 64 * hd, (unsigned)(n), __ATOMIC_RELAXED, __HIP_MEMORY_SCOPE_AGENT); \
            bf16x8 sf[4]; \
            _Pragma("unroll") for (int ks = 0; ks < 4; ++ks) { sf[ks] = pack8(St[2 * ks], St[2 * ks + 1]); SFR[((size_t)(cu * 8 + sl) * 4 + ks) * 64 + lane] = __builtin_bit_cast(u32x4, sf[ks]); } \
            f32x4 vn[4]; \
            _Pragma("unroll") for (int rb = 0; rb < 4; ++rb) { f32x4 a = (f32x4){0.f, 0.f, 0.f, 0.f}; \
                _Pragma("unroll") for (int ks = 0; ks < 4; ++ks) { const bf16x8 wf = *(const LAS bf16x8*)(B + offb(16 * rb + col, 4 * ks + g)); a = MFMA16(wf, sf[ks], a); } \
                vn[rb] = U[rb] - a; } \
            SC_UT(U, (n) + 4); \
            bf16x8 vf[2]; \
            _Pragma("unroll") for (int k2 = 0; k2 < 2; ++k2) { vf[k2] = pack8(vn[2 * k2], vn[2 * k2 + 1]); VFR[((size_t)(cu * 8 + sl) * 2 + k2) * 64 + lane] = __builtin_bit_cast(u32x4, vf[k2]); } \
            _Pragma("unroll") for (int tt = 0; tt < 8; ++tt) { f32x4 s_ = St[tt] * dec_; \
                _Pragma("unroll") for (int k2 = 0; k2 < 2; ++k2) { const bf16x8 kd = *(const LAS bf16x8*)(B + 16384 + off128(16 * tt + col, 4 * k2 + g)); s_ = MFMA16(kd, vf[k2], s_); } \
                St[tt] = s_; } \
            asm volatile("s_waitcnt lgkmcnt(0)" ::: "memory"); \
            __builtin_amdgcn_s_barrier(); } while (0)
        for (int n = 0; n < NCH; n += 4) { SC_STEP(n, utA); SC_STEP(n + 1, utB); SC_STEP(n + 2, utC); SC_STEP(n + 3, utD); }
#undef SC_STEP
#undef SC_UT
    }
    __syncthreads();
}


__device__ __forceinline__ void scan_helper(Frame& F, int hd, int hw, int nhw) {
    unsigned char* ws = F.ws; const int lane = F.lane;
    const bf16* KDT = (const bf16*)(ws + WS_KDT); const bf16* WW = (const bf16*)(ws + WS_WW); const float* UT = (const float*)(ws + WS_UT);
    unsigned* prog = (unsigned*)(ws + WS_CTL) + CW_PROG + 64 * hd;
    constexpr int WIN = 24;
    unsigned sink = 0u;
    for (int m = hw; m < NCH; m += nhw) {
        unsigned spins = 0;
        while (m > (int)__builtin_amdgcn_readfirstlane(__hip_atomic_load(prog, __ATOMIC_RELAXED, __HIP_MEMORY_SCOPE_AGENT)) + WIN) { __builtin_amdgcn_s_sleep(16); if (++spins > (1u << 20)) break; }
        const int cu = m * 8 + hd;
        const char* pw = (const char*)(WW + ((size_t)m * 64 + lane) * 1024 + hd * 128);
        const char* pk = (const char*)(KDT + (size_t)cu * 128 * 64) + lane * 128;
        const char* pu = (const char*)(UT + (size_t)cu * 128 * 64) + lane * 128;
        const char* pw1 = pw + 128; const char* pk1 = pk + 8192; const char* pu1 = pu + 8192; const char* pu2 = pu + 16384; const char* pu3 = pu + 24576;
        asm volatile("global_load_dword %0, %1, off" : "+v"(sink) : "v"(pw) : "memory"); asm volatile("global_load_dword %0, %1, off" : "+v"(sink) : "v"(pw1) : "memory");
        asm volatile("global_load_dword %0, %1, off" : "+v"(sink) : "v"(pk) : "memory"); asm volatile("global_load_dword %0, %1, off" : "+v"(sink) : "v"(pk1) : "memory");
        asm volatile("global_load_dword %0, %1, off" : "+v"(sink) : "v"(pu) : "memory"); asm volatile("global_load_dword %0, %1, off" : "+v"(sink) : "v"(pu1) : "memory");
        asm volatile("global_load_dword %0, %1, off" : "+v"(sink) : "v"(pu2) : "memory"); asm volatile("global_load_dword %0, %1, off" : "+v"(sink) : "v"(pu3) : "memory");
        asm volatile("s_waitcnt vmcnt(0)" : "+v"(sink) :: "memory");
    }
}

__device__ __forceinline__ void delta_out_wg(Frame& F, int cu, int parity) {
    unsigned char* ws = F.ws; const int lane = F.lane, col = lane & 15, g = lane >> 4, chunk = cu >> 3, hd = cu & 7, t0 = chunk * 64, sl = F.wave;
    const bf16* QDEC = (const bf16*)(ws + WS_QDEC); const bf16* QKM = (const bf16*)(ws + WS_QKM); const bf16* Z = (const bf16*)(ws + WS_Z);
    const u32x4* SFR = (const u32x4*)(ws + WS_SFRAG); const u32x4* VFR = (const u32x4*)(ws + WS_VFRAG); bf16* MIX = (bf16*)(ws + WS_MIX); const float* gd = F.in[IN_GDOUT];
    LAS float* xs = (LAS float*)(F.lds + parity * 4096);
    bf16x8 sf[4], vf[2];
#pragma unroll
    for (int ks = 0; ks < 4; ++ks) sf[ks] = __builtin_bit_cast(bf16x8, SFR[((size_t)(cu * 8 + sl) * 4 + ks) * 64 + lane]);
#pragma unroll
    for (int k2 = 0; k2 < 2; ++k2) vf[k2] = __builtin_bit_cast(bf16x8, VFR[((size_t)(cu * 8 + sl) * 2 + k2) * 64 + lane]);
    unsigned short zr[4][4];
#pragma unroll
    for (int rb = 0; rb < 4; ++rb)
#pragma unroll
        for (int i = 0; i < 4; ++i) zr[rb][i] = Z[(size_t)(t0 + 16 * rb + 4 * g + i) * 1024 + hd * 128 + 16 * sl + col];
    const float gg = gd[16 * sl + col];
    f32x4 o[4];
#pragma unroll
    for (int rb = 0; rb < 4; ++rb) { f32x4 a = (f32x4){0.f, 0.f, 0.f, 0.f};
#pragma unroll
        for (int ks = 0; ks < 4; ++ks) { const bf16x8 qf = *(const bf16x8*)(QDEC + (size_t)(t0 + 16 * rb + col) * 1024 + hd * 128 + 32 * ks + 8 * g); a = MFMA16(qf, sf[ks], a); }
#pragma unroll
        for (int k2 = 0; k2 < 2; ++k2) { const bf16x8 qk = *(const bf16x8*)(QKM + (size_t)cu * 4096 + (16 * rb + col) * 64 + 32 * k2 + 8 * g); a = MFMA16(qk, vf[k2], a); }
        o[rb] = a;
        f32x4 ss = a * a;
#pragma unroll
        for (int i = 0; i < 4; ++i) { float v = ss[i]; v += __shfl_xor(v, 1); v += __shfl_xor(v, 2); v += __shfl_xor(v, 4); v += __shfl_xor(v, 8); ss[i] = v; }
        if (col == 0) *(LAS f32x4*)(xs + sl * 64 + 16 * rb + 4 * g) = ss; }
    __syncthreads();
#pragma unroll
    for (int rb = 0; rb < 4; ++rb) { f32x4 tot = (f32x4){0.f, 0.f, 0.f, 0.f};
#pragma unroll
        for (int s8 = 0; s8 < 8; ++s8) tot += *(const LAS f32x4*)(xs + s8 * 64 + 16 * rb + 4 * g);
#pragma unroll
        for (int i = 0; i < 4; ++i) { const float rstd = __builtin_amdgcn_rsqf(tot[i] * (1.f / 128.f) + EPS); const float zv = bf2f(zr[rb][i]);
            const float r = o[rb][i] * rstd * gg * zv * __builtin_amdgcn_rcpf(1.f + __expf(-zv));
            MIX[(size_t)(t0 + 16 * rb + 4 * g + i) * 2048 + 1024 + hd * 128 + 16 * sl + col] = (bf16)(pk2(r, 0.f) & 0xffffu); } }
}

__device__ __forceinline__ void route_tokens(Frame& F, int tbeg, int tend) {
    unsigned char* ws = F.ws;
    const float* SSQ = (const float*)(ws + WS_SSQ2); const float* LG = (const float*)(ws + WS_LOGITS); float* RSTD2 = (float*)(ws + WS_RSTD2); float* WGT = (float*)(ws + WS_WGT);
    int* LIST = (int*)(ws + WS_LIST); unsigned* cnt = (unsigned*)(ws + WS_CTL) + CW_CNT;
    const float* bg = F.in[IN_BGROUP]; const float* be = F.in[IN_BEXPERT];
    for (int t = tbeg + F.tid; t < tend; t += 512) {
        float ss = 0.f;
#pragma unroll
        for (int i = 0; i < 8; ++i) { const f32x4 v = *(const f32x4*)(SSQ + (size_t)t * 32 + 4 * i); ss += (v[0] + v[1]) + (v[2] + v[3]); }
        const float rstd = __builtin_amdgcn_rsqf(ss * (1.f / D) + EPS);
        RSTD2[t] = rstd;
        const float* lg = LG + (size_t)t * 256;
        float gl[8]; float gmax = -__builtin_inff(); int gsel = 0;
#pragma unroll
        for (int i = 0; i < 8; ++i) { gl[i] = lg[i] * rstd + bg[i]; if (gl[i] > gmax) { gmax = gl[i]; gsel = i; } }
        float gsum = 0.f;
#pragma unroll
        for (int i = 0; i < 8; ++i) gsum += __expf(gl[i] - gmax);
        const float gate = 1.f / gsum;
        float v1 = -__builtin_inff(), v2 = -__builtin_inff(); int i1 = 0, i2 = 0;
#pragma unroll
        for (int i = 0; i < 8; ++i) { const float e = lg[8 + gsel * 8 + i] * rstd + be[gsel * 8 + i];
            if (e > v1) { v2 = v1; i2 = i1; v1 = e; i1 = i; } else if (e > v2) { v2 = e; i2 = i; } }
        const float w1 = 1.f / (1.f + __expf(v2 - v1)), w2 = 1.f - w1;
        const int e1 = gsel * 8 + i1, e2 = gsel * 8 + i2;
        const unsigned p1 = atomicAdd(cnt + e1 * 16, 1u); LIST[(size_t)e1 * 16384 + p1] = t * 2; WGT[t * 2] = gate * w1;
        const unsigned p2 = atomicAdd(cnt + e2 * 16, 1u); LIST[(size_t)e2 * 16384 + p2] = t * 2 + 1; WGT[t * 2 + 1] = gate * w2;
    }
}
__device__ __forceinline__ void build_ptab(Frame& F) {
    LAS int* pt = (LAS int*)(F.lds + PTAB_OFF);
    if (F.tid == 0) { unsigned* cnt = (unsigned*)(F.ws + WS_CTL) + CW_CNT; int np = 0;
        for (int e = 0; e < NEXP; ++e) { const int c = (int)__hip_atomic_load(cnt + e * 16, __ATOMIC_RELAXED, __HIP_MEMORY_SCOPE_AGENT);
            for (int off = 0; off < c; off += 256) { pt[np] = e; pt[192 + np] = off; pt[384 + np] = c; ++np; } }
        pt[576] = np; }
    __syncthreads();
}
__device__ __forceinline__ void final_rows(Frame& F) {
    const int gw = F.vcu * 8 + F.wave, NGW = F.G * 8; const bf16* Y = (const bf16*)(F.ws + WS_Y); const float* gf = F.in[IN_GFINAL];
    f32x4 gv[8];
#pragma unroll
    for (int j = 0; j < 8; ++j) gv[j] = *(const f32x4*)(gf + 4 * F.lane + 256 * j);
    for (int row = gw; row < S; row += NGW) {
        float* hr = F.out + (size_t)row * D; const bf16* hb = (const bf16*)(F.ws + WS_H2B) + (size_t)row * D; f32x4 v[8]; float ss = 0.f;
#pragma unroll
        for (int j = 0; j < 8; ++j) { { const u32x2 t = *(const u32x2*)(hb + 4 * F.lane + 256 * j); v[j] = (f32x4){__uint_as_float(t.x << 16), __uint_as_float(t.x & 0xffff0000u), __uint_as_float(t.y << 16), __uint_as_float(t.y & 0xffff0000u)}; }
            const u32x2 a = *(const u32x2*)(Y + (size_t)row * D + 4 * F.lane + 256 * j), b = *(const u32x2*)(Y + ((size_t)S + row) * D + 4 * F.lane + 256 * j);
            v[j][0] += __uint_as_float(a.x << 16) + __uint_as_float(b.x << 16); v[j][1] += __uint_as_float(a.x & 0xffff0000u) + __uint_as_float(b.x & 0xffff0000u);
            v[j][2] += __uint_as_float(a.y << 16) + __uint_as_float(b.y << 16); v[j][3] += __uint_as_float(a.y & 0xffff0000u) + __uint_as_float(b.y & 0xffff0000u);
            ss += (v[j][0] * v[j][0] + v[j][1] * v[j][1]) + (v[j][2] * v[j][2] + v[j][3] * v[j][3]); }
        const float rstd = __builtin_amdgcn_rsqf(wave_sum(ss) * (1.f / D) + EPS);
#pragma unroll
        for (int j = 0; j < 8; ++j) *(f32x4*)(hr + 4 * F.lane + 256 * j) = v[j] * rstd * gv[j];
    }
}

constexpr int NPH = 14;
struct Args { const float* in[24]; float* out; unsigned char* ws; int ph_lo, ph_hi; };
__global__ void __launch_bounds__(512, 2) mk_fwd(Args args) {
    extern __shared__ __attribute__((aligned(16))) unsigned char lds_raw[];
    Frame F;
    F.lds = (LAS unsigned char*)lds_raw;
    F.tid = threadIdx.x; F.lane = F.tid & 63; F.wave = __builtin_amdgcn_readfirstlane(F.tid >> 6);
    F.G = gridDim.x; { const int bx = blockIdx.x; F.vcu = (F.G % 8 == 0) ? (bx % 8) * (F.G / 8) + bx / 8 : bx; }
#pragma unroll
    for (int i = 0; i < 24; ++i) F.in[i] = args.in[i];
    F.out = args.out; F.ws = args.ws;
    unsigned char* ws = args.ws;
    volatile LAS unsigned* MISC = (volatile LAS unsigned*)(F.lds + MISC_OFF);
    if (F.tid < 64) MISC[F.tid] = 0u;
    __syncthreads();
    const int lo = args.ph_lo, hi = args.ph_hi;
    XcdBarrier bar; bar.bar = (unsigned*)(ws + WS_CTL) + CW_BAR; bar.x = 0; bar.st = nullptr;
    if (hi - lo > 1) bar = xcd_barrier_post((unsigned*)(ws + WS_CTL) + CW_BAR, MISC + 8);
#ifndef PH_MASK
#define PH_MASK 0xFFFFFFFFu
#endif
#define IN(k) (((PH_MASK >> (k)) & 1u) && lo <= (k) && (k) < hi)
#define TS_MULT 4
    unsigned long long* TSW = (unsigned long long*)(ws + WS_CTL + 32768);
#define STAMP(i) do { if (TS_A >= 0) { __hip_atomic_store(TSW + (i), (unsigned long long)__builtin_amdgcn_s_memrealtime(), __ATOMIC_RELAXED, __HIP_MEMORY_SCOPE_AGENT); } } while (0)
#define STAMPMAX(i) do { if (TS_A >= 0 && threadIdx.x == 0) { __hip_atomic_fetch_max(TSW + (i), (unsigned long long)__builtin_amdgcn_s_memrealtime(), __ATOMIC_RELAXED, __HIP_MEMORY_SCOPE_AGENT); } } while (0)
#define STAMP0(i) do { if (TS_A >= 0 && blockIdx.x == 0 && threadIdx.x == 0) STAMP(i); } while (0)
#ifndef DUP_MASK
#define DUP_MASK 0u
#endif
#define REP(k) for (int rep_ = 0; rep_ < (((DUP_MASK >> (k)) & 1u) ? 2 : 1); ++rep_)
#define SEAM(k) do { if (IN(k) && IN((k) + 1)) xcd_barrier(bar); } while (0)
    const int bx = blockIdx.x;
    STAMP0(0);
    if (IN(0)) { REP(0) p0_prologue(F); SEAM(0); }
    STAMP0(1);
    if (IN(1)) { REP(1) {
        pg8::Gemm g{(const bf16*)(ws + WS_XN), (const bf16*)(ws + WS_WIN), D, 0, nullptr}; pg8::StaticOrder So; So.init(S, NPROJ, F.G, bx);
        EpiProj E{(bf16*)(ws + WS_QKVA), (bf16*)(ws + WS_QKVD), (bf16*)(ws + WS_Z)};
        pg8::gemm_phase<EpiProj, pg8::StaticOrder, true, true, false>(F.lds, g, So, E); }
        SEAM(1);
    }
    STAMP0(2);
    if (IN(2)) { REP(2) for (int cu = F.vcu * 8 + F.wave; cu < NCH * 8; cu += F.G * 8) delta_prep_unit(F, cu, TSW); SEAM(2); }
    STAMP0(3);
    if (IN(3)) {
        if (bx < 32) { REP(14) delta_scan2<2>(F, bx & 7, bx >> 3); STAMP0(20); STAMPMAX(30); }
        else if (bx < 64) { scan_helper(F, bx & 7, ((bx - 32) >> 3) * 8 + F.wave, 32); __syncthreads(); STAMPMAX(31); }
        else { const int naw = (F.G - 64) * 8;
               REP(3) { for (int wu = (bx - 64) * 8 + F.wave; wu < 3 * 8 * 512; wu += naw) dilated_unit(F, wu); }
               if (TS_A >= 0 && bx == 64 && F.tid == 0) STAMP(21);
               convert_from_queue(F, TI_SPLIT1, (LAS float*)(F.lds + F.wave * WAVE_LDS));
               if (TS_A >= 0 && bx == 64 && F.tid == 0) STAMP(22); __syncthreads(); STAMPMAX(32); }
        if (bx < 64) convert_from_queue(F, TI_SPLIT1, (LAS float*)(F.lds + F.wave * WAVE_LDS));
        SEAM(3);
    }
    STAMP0(4);
    if (IN(4)) { REP(4) { { int par = 0; for (int cu = F.vcu; cu < NCH * 8; cu += F.G) { delta_out_wg(F, cu, par); par ^= 1; } __syncthreads(); } STAMP0(23); for (int t = F.vcu * 8 + F.wave; t < S; t += F.G * 8) merge_token(F, t); } SEAM(4); }
    STAMP0(5);
    if (IN(5)) { REP(5) {
        pg8::Gemm g{(const bf16*)(ws + WS_MIX), (const bf16*)(ws + WS_WOUT), D, 0, nullptr}; pg8::StaticOrder So; So.init(S, D, F.G, bx);
        EpiResid<false> E{F.in[IN_X], (bf16*)(ws + WS_H1B), (float*)(ws + WS_SSQ1)};
        pg8::gemm_phase<EpiResid<false>, pg8::StaticOrder, true, true, false>(F.lds, g, So, E); }
        SEAM(5);
    }
    STAMP0(6);
    if (IN(6)) { REP(6) {
        { pg8::Gemm g{(const bf16*)(ws + WS_H1B), (const bf16*)(ws + WS_WQ), D, 0, nullptr}; pg8::StaticOrder So; So.init(S, 512, F.G, bx);
          EpiBf16 E{(bf16*)(ws + WS_QMEM), 512};
          pg8::gemm_phase<EpiBf16, pg8::StaticOrder, true, true, false>(F.lds, g, So, E); }
        { pg8::Gemm g{(const bf16*)(ws + WS_MEMN), (const bf16*)(ws + WS_WKV), D, 0, nullptr}; pg8::StaticOrder So; So.init(NMEM, 1024, F.G, (bx >= 128 && bx < 132) ? bx - 128 : -1);
          EpiBf16 E{(bf16*)(ws + WS_KVMEM), 1024};
          pg8::gemm_phase<EpiBf16, pg8::StaticOrder, true, true, false>(F.lds, g, So, E); } }
        if (bx >= 132) transpose_items<true>(F, TI_SPLIT1 + (bx - 132) * 8 + F.wave, TI_SPLIT2, (F.G - 132) * 8, (LAS float*)(F.lds + F.wave * WAVE_LDS));
        SEAM(6);
    }
    STAMP0(7);
    if (IN(7)) { REP(7) for (int u = bx; u < 256; u += F.G) cross_unit(F, u); SEAM(7); }
    STAMP0(8);
    if (IN(8)) {
        pg8::Gemm g{(const bf16*)(ws + WS_OMEM), (const bf16*)(ws + WS_WO), 512, 0, nullptr}; pg8::StaticOrder So; So.init(S, D, F.G, bx);
        EpiResid<true> E{(const void*)(ws + WS_H1B), (bf16*)(ws + WS_H2B), (float*)(ws + WS_SSQ2)};
        pg8::gemm_phase<EpiResid<true>, pg8::StaticOrder, true, true, false>(F.lds, g, So, E);
        SEAM(8);
    }
    STAMP0(9);
    if (IN(9)) { REP(9) {
        pg8::Gemm g{(const bf16*)(ws + WS_H2B), (const bf16*)(ws + WS_WR), D, 0, nullptr}; pg8::StaticOrder So; So.init(S, 256, F.G, bx);
        EpiF32 E{(float*)(ws + WS_LOGITS), 256};
        pg8::gemm_phase<EpiF32, pg8::StaticOrder, true, true, false>(F.lds, g, So, E);
        { pg8::Unit u0; if (So.next(0, u0)) { asm volatile("s_waitcnt vmcnt(0)" ::: "memory"); __syncthreads(); route_tokens(F, u0.pm * 256, u0.pm * 256 + 256); } } }
        if (bx >= 64) transpose_items<true>(F, TI_SPLIT2 + (bx - 64) * 8 + F.wave, TI_NMOE, (F.G - 64) * 8, (LAS float*)(F.lds + F.wave * WAVE_LDS));
        SEAM(9);
    }
    STAMP0(10);
    if (IN(10)) { }
    STAMP0(11);
    if (IN(11)) { REP(11) {
        build_ptab(F);
        pg8::Gemm g{(const bf16*)(ws + WS_H2B), (const bf16*)(ws + WS_WGU), D, (size_t)1024 * D, (const int*)(ws + WS_LIST)};
        pg8::MoeOrder<2> So{(const LAS int*)(F.lds + PTAB_OFF), F.G, F.vcu};
        EpiHid E{(bf16*)(ws + WS_HID), (const int*)(ws + WS_LIST), (const float*)(ws + WS_RSTD2)};
        pg8::gemm_phase<EpiHid, pg8::MoeOrder<2>, true, true, true>(F.lds, g, So, E); }
        SEAM(11);
    }
    STAMP0(12);
    if (IN(12)) { REP(12) {
        build_ptab(F);
        pg8::Gemm g{(const bf16*)(ws + WS_HID), (const bf16*)(ws + WS_WD), DE, (size_t)D * DE, nullptr};
        pg8::MoeOrder<3> So{(const LAS int*)(F.lds + PTAB_OFF), F.G, F.vcu};
        EpiDown E{(bf16*)(ws + WS_Y), (const int*)(ws + WS_LIST), (const float*)(ws + WS_WGT)};
        pg8::gemm_phase<EpiDown, pg8::MoeOrder<3>, true, true, false>(F.lds, g, So, E); }
        SEAM(12);
    }
    STAMP0(13);
    if (IN(13)) final_rows(F);
    STAMP0(14);
    if (TS_A >= 0 && blockIdx.x == 0 && threadIdx.x == 0) {
        asm volatile("s_waitcnt vmcnt(0)" ::: "memory");
        const unsigned long long ta = __hip_atomic_load(TSW + TS_A, __ATOMIC_RELAXED, __HIP_MEMORY_SCOPE_AGENT), tb = __hip_atomic_load(TSW + TS_B, __ATOMIC_RELAXED, __HIP_MEMORY_SCOPE_AGENT);
        const unsigned long long dl = (tb > ta ? tb - ta : 0ull) * TS_MULT, t0 = __builtin_amdgcn_s_memrealtime();
        while (__builtin_amdgcn_s_memrealtime() - t0 < dl) __builtin_amdgcn_s_sleep(8);
    }
#undef IN
#undef SEAM
}

extern "C" void kernel_launch(void* const* d_in, const int* in_sizes, int n_in, void* d_out, int out_size, void* d_ws, size_t ws_size, hipStream_t stream) {
    static int grid = 0;
    if (grid == 0) {
        if (n_in != 24 || out_size != S * D || ws_size < WS_END) { fprintf(stderr, "kernel_launch: unexpected shapes (n_in %d out %d ws %zu)\n", n_in, out_size, ws_size); grid = -1; return; }
        int dev = 0, cus = 0;
        if (hipGetDevice(&dev) != hipSuccess || hipDeviceGetAttribute(&cus, hipDeviceAttributeMultiprocessorCount, dev) != hipSuccess) { grid = -1; return; }
        if (hipFuncSetAttribute((const void*)mk_fwd, hipFuncAttributeMaxDynamicSharedMemorySize, LDS_BYTES) != hipSuccess) { fprintf(stderr, "kernel_launch: hipFuncSetAttribute failed\n"); grid = -1; return; }
        int per_cu = 0; (void)hipOccupancyMaxActiveBlocksPerMultiprocessor(&per_cu, (const void*)mk_fwd, 512, LDS_BYTES); (void)hipGetLastError();
        grid = cus;
        if (grid % 8 != 0 || grid < 64) { fprintf(stderr, "kernel_launch: unexpected CU count %d\n", cus); }
    }
    if (grid < 0) return;
    (void)hipMemsetAsync((char*)d_ws + WS_CTL, 0, CTL_ZERO_BYTES, stream);
    Args a{};
    for (int i = 0; i < 24; ++i) a.in[i] = (const float*)d_in[i];
    a.out = (float*)d_out; a.ws = (unsigned char*)d_ws;
#if MK_N_LAUNCHES == 1
    a.ph_lo = 0; a.ph_hi = NPH;
    hipLaunchKernelGGL(mk_fwd, dim3(grid), dim3(512), LDS_BYTES, stream, a);
#else
    for (int p = 0; p < NPH; ++p) { a.ph_lo = p; a.ph_hi = p + 1; hipLaunchKernelGGL(mk_fwd, dim3(grid), dim3(512), LDS_BYTES, stream, a); }
#endif
}
```
